# Optimizing an MI355X kernel written in HIP

```python
import math
import jax, jax.numpy as jnp
from jax import lax
import numpy as np

D_MODEL = 1024
BATCH = 16
SEQ = 4096
DEPTH = 1
DEC_BATCH = 8
DEC_SEQ = 16
PAST_LEN = 2048

CHUNK = 64
EPS = 1e-6
N_MOD = 6
HG_HEADS = 8
HG_DK = 128
HG_DV = D_MODEL // HG_HEADS
HG_WIDTH = HG_HEADS * HG_DV
HG_KW = HG_HEADS * HG_DK
SSM_EXPAND = 2
SSM_D_INNER = SSM_EXPAND * D_MODEL
SSM_HEADDIM = 64
SSM_HEADS = SSM_D_INNER // SSM_HEADDIM
SSM_GROUPS = 4
SSM_HPG = SSM_HEADS // SSM_GROUPS
SSM_STATE = 128
SSM_CONV = 4
SSM_XBC = SSM_D_INNER + 2 * SSM_GROUPS * SSM_STATE
IN_SIZES = (HG_KW, HG_KW, HG_WIDTH, HG_WIDTH, SSM_D_INNER, SSM_XBC, SSM_HEADS, D_MODEL, D_MODEL)
IN_COLS = sum(IN_SIZES)
PEER_HEADS = 8
PEER_NKEYS = 128
PEER_EXPERTS = PEER_NKEYS * PEER_NKEYS
PEER_TOPK = 16
PEER_DK = 256
PEER_DK_HALF = PEER_DK // 2
PEER_BLOCK = 256

kernel_name = 'hgrn2_mamba2_peer_adaln_stream_step'


def _rms(x):
    xf = x.astype(jnp.float32)
    return xf * lax.rsqrt(jnp.mean(xf * xf, axis=-1, keepdims=True) + EPS)


def _to_blocks(a, blk):
    b, t = a.shape[0], a.shape[1]
    return jnp.moveaxis(a.reshape((b, t // blk, blk) + a.shape[2:]), 1, 0)


def _from_blocks(a):
    n, b, l = a.shape[0], a.shape[1], a.shape[2]
    return jnp.moveaxis(a, 0, 1).reshape((b, n * l) + a.shape[3:])


def _gla_chunked(q, k, v, logf, s0, blk):
    causal = jnp.tril(jnp.ones((blk, blk), dtype=bool))[None, :, :, None, None]

    def step(s, inp):
        qb, kb, vb, gb = inp
        g = jnp.cumsum(gb, axis=1)
        decay = jnp.exp(jnp.where(causal, g[:, :, None] - g[:, None, :], -jnp.inf))
        att = jnp.einsum('bihk,bjhk,bijhk->bhij', qb, kb, decay)
        o = (jnp.einsum('bhij,bjhv->bihv', att, vb)
             + jnp.einsum('bihk,bhkv->bihv', qb * jnp.exp(g), s))
        g_last = g[:, -1]
        s = (jnp.exp(g_last)[..., None] * s
             + jnp.einsum('bjhk,bjhv->bhkv', kb * jnp.exp(g_last[:, None] - g), vb))
        return s, o

    s_fin, o = lax.scan(step, s0, (_to_blocks(q, blk), _to_blocks(k, blk),
                                   _to_blocks(v, blk), _to_blocks(logf, blk)))
    return _from_blocks(o), s_fin


def _ssd_chunked(x, dt, a_neg, bm, cm, s0, blk):
    bn, t = x.shape[0], x.shape[1]
    xg = x.reshape(bn, t, SSM_GROUPS, SSM_HPG, SSM_HEADDIM)
    dtg = dt.reshape(bn, t, SSM_GROUPS, SSM_HPG)
    ag = (dt * a_neg).reshape(bn, t, SSM_GROUPS, SSM_HPG)
    h0 = s0.reshape(bn, SSM_GROUPS, SSM_HPG, SSM_HEADDIM, SSM_STATE)
    causal = jnp.tril(jnp.ones((blk, blk), dtype=bool))

    def step(h, inp):
        xb, dtb, ab, bb, cb = inp
        acum = jnp.cumsum(ab, axis=1)
        ac = jnp.transpose(acum, (0, 2, 3, 1))
        dtt = jnp.transpose(dtb, (0, 2, 3, 1))
        seg = jnp.exp(jnp.where(causal, ac[..., :, None] - ac[..., None, :], -jnp.inf))
        cbm = jnp.einsum('bign,bjgn->bgij', cb, bb)
        w = cbm[:, :, None] * seg * dtt[..., None, :]
        y = (jnp.einsum('bgrij,bjgrp->bigrp', w, xb)
             + jnp.einsum('bign,bgrpn->bigrp', cb, h) * jnp.exp(acum)[..., None])
        a_last = ac[..., -1]
        wd = jnp.exp(a_last[..., None] - ac) * dtt
        h = (jnp.exp(a_last)[..., None, None] * h
             + jnp.einsum('bjgn,bgrj,bjgrp->bgrpn', bb, wd, xb))
        return h, y

    h_fin, y = lax.scan(step, h0, (_to_blocks(xg, blk), _to_blocks(dtg, blk), _to_blocks(ag, blk),
                                   _to_blocks(bm, blk), _to_blocks(cm, blk)))
    y = _from_blocks(y).reshape(bn, t, SSM_HEADS, SSM_HEADDIM)
    return y, h_fin.reshape(bn, SSM_HEADS, SSM_HEADDIM, SSM_STATE)


def _token_mixer(h, s_hg, s_ssm, conv_buf, lb, w_in, hg_norm_w, conv_w, conv_b, dt_bias, a_log,
                 ssm_d, ssm_norm_w, w_branch_a, w_branch_b, w_out):
    f32 = jnp.float32
    bn, t = h.shape[0], h.shape[1]
    blk = min(CHUNK, t)
    proj = h @ w_in
    cuts = []
    acc = 0
    for s in IN_SIZES[:-1]:
        acc += s
        cuts.append(acc)
    q_r, f_r, i_r, g_r, z, xbc, dt_r, ga_r, gb_r = jnp.split(proj, cuts, axis=-1)

    q = jax.nn.silu(q_r.astype(f32)).reshape(bn, t, HG_HEADS, HG_DK)
    ff = f_r.astype(f32)
    logf = jnp.log(lb + (1.0 - lb) * jax.nn.sigmoid(ff)).reshape(bn, t, HG_HEADS, HG_DK)
    k = ((1.0 - lb) * jax.nn.sigmoid(-ff)).reshape(bn, t, HG_HEADS, HG_DK)
    v = i_r.astype(f32).reshape(bn, t, HG_HEADS, HG_DV)
    o, s_hg_new = _gla_chunked(q, k, v, logf, s_hg.astype(f32), blk)
    o = (_rms(o) * hg_norm_w.astype(f32).reshape(HG_HEADS, HG_DV)).reshape(bn, t, HG_WIDTH)
    o = (o * jax.nn.silu(g_r.astype(f32))).astype(h.dtype)
    pa = o @ w_branch_a

    xp = jnp.concatenate([conv_buf.astype(xbc.dtype), xbc], axis=1)
    conv_new = xp[:, xp.shape[1] - (SSM_CONV - 1):]
    xc = conv_b + xp[:, 0:t] * conv_w[0]
    for j in range(1, SSM_CONV):
        xc = xc + xp[:, j:j + t] * conv_w[j]
    xc = jax.nn.silu(xc.astype(f32))
    xs, bm, cm = jnp.split(xc, [SSM_D_INNER, SSM_D_INNER + SSM_GROUPS * SSM_STATE], axis=-1)
    xs = xs.reshape(bn, t, SSM_HEADS, SSM_HEADDIM)
    bm = bm.reshape(bn, t, SSM_GROUPS, SSM_STATE)
    cm = cm.reshape(bn, t, SSM_GROUPS, SSM_STATE)
    dt = jax.nn.softplus(dt_r.astype(f32) + dt_bias.astype(f32))
    a_neg = -jnp.exp(a_log.astype(f32))
    y, s_ssm_new = _ssd_chunked(xs, dt, a_neg, bm, cm, s_ssm.astype(f32), blk)
    y = y + ssm_d.astype(f32)[:, None] * xs
    y = y.reshape(bn, t, SSM_D_INNER) * jax.nn.silu(z.astype(f32))
    y = _rms(y.reshape(bn, t, SSM_GROUPS, SSM_D_INNER // SSM_GROUPS)).reshape(bn, t, SSM_D_INNER)
    y = (y * ssm_norm_w.astype(f32)).astype(h.dtype)
    pb = y @ w_branch_b

    merged = jax.nn.sigmoid(ga_r) * pa + jax.nn.sigmoid(gb_r) * pb
    return (merged @ w_out, s_hg_new.astype(s_hg.dtype), s_ssm_new.astype(s_ssm.dtype),
            conv_new.astype(conv_buf.dtype))


def _peer(h, wq, keys1, keys2, u, v):
    f32 = jnp.float32
    bn, t, d = h.shape
    n = bn * t
    blk = min(PEER_BLOCK, n)
    pad = (-n) % blk
    tok = jnp.pad(h.reshape(n, d), ((0, pad), (0, 0))).reshape(-1, blk, d)
    k1 = keys1.astype(f32)
    k2 = keys2.astype(f32)

    def one(tb):
        q = (tb @ wq).astype(f32).reshape(blk, PEER_HEADS, 2, PEER_DK_HALF)
        s1 = jnp.einsum('thd,hkd->thk', q[:, :, 0], k1)
        s2 = jnp.einsum('thd,hkd->thk', q[:, :, 1], k2)
        v1, i1 = lax.top_k(s1, PEER_TOPK)
        v2, i2 = lax.top_k(s2, PEER_TOPK)
        cand = (v1[..., :, None] + v2[..., None, :]).reshape(blk, PEER_HEADS, PEER_TOPK * PEER_TOPK)
        cidx = (i1[..., :, None] * PEER_NKEYS + i2[..., None, :]).reshape(blk, PEER_HEADS, PEER_TOPK * PEER_TOPK)
        sv, si = lax.top_k(cand, PEER_TOPK)
        eidx = jnp.take_along_axis(cidx, si, axis=-1)
        gw = jax.nn.softmax(sv, axis=-1)
        ue = jnp.take(u, eidx, axis=0)
        act = jax.nn.gelu(jnp.einsum('td,thed->the', tb, ue).astype(f32), approximate=False)
        ve = jnp.take(v, eidx, axis=0)
        return jnp.einsum('the,thed->td', (gw * act).astype(tb.dtype), ve)

    out = lax.map(one, tok).reshape(-1, d)[:n]
    return out.reshape(bn, t, d)


def _layer(x, c, s_hg, s_ssm, conv_buf, lb, w_ada, b_ada, norm1_w, w_in, hg_norm_w, conv_w, conv_b,
           dt_bias, a_log, ssm_d, ssm_norm_w, w_branch_a, w_branch_b, w_out, norm2_w,
           peer_wq, peer_keys1, peer_keys2, peer_u, peer_v):
    mod = (jax.nn.silu(c) @ w_ada + b_ada)[:, None, :]
    sh1, sc1, g1, sh2, sc2, g2 = jnp.split(mod, N_MOD, axis=-1)
    h = (_rms(x) * norm1_w * (1.0 + sc1) + sh1).astype(x.dtype)
    mix, s_hg_new, s_ssm_new, conv_new = _token_mixer(
        h, s_hg, s_ssm, conv_buf, lb, w_in, hg_norm_w, conv_w, conv_b, dt_bias, a_log,
        ssm_d, ssm_norm_w, w_branch_a, w_branch_b, w_out)
    x = x + g1 * mix
    h2 = (_rms(x) * norm2_w * (1.0 + sc2) + sh2).astype(x.dtype)
    x = x + g2 * _peer(h2, peer_wq, peer_keys1, peer_keys2, peer_u, peer_v)
    return x, s_hg_new, s_ssm_new, conv_new


def setup_inputs(seed: int = 0) -> dict:
    key = jax.random.key(seed)
    ks = jax.random.split(key, 32)
    nrm = jax.random.normal
    f32 = jnp.float32
    dt0 = jnp.exp(jax.random.uniform(ks[14], (DEPTH, SSM_HEADS), minval=math.log(1e-3), maxval=math.log(1e-1)))
    return {
        'x_prompt': nrm(ks[0], (BATCH, SEQ, D_MODEL), f32),
        'x_sample': nrm(ks[1], (DEC_BATCH, DEC_SEQ, D_MODEL), f32),
        'c_prompt': nrm(ks[2], (BATCH, D_MODEL), f32),
        'c_sample': nrm(ks[3], (DEC_BATCH, D_MODEL), f32),
        'state_hgrn': 0.5 * nrm(ks[4], (DEPTH, DEC_BATCH, HG_HEADS, HG_DK, HG_DV), f32),
        'state_ssm': 0.1 * nrm(ks[5], (DEPTH, DEC_BATCH, SSM_HEADS, SSM_HEADDIM, SSM_STATE), f32),
        'state_conv': nrm(ks[6], (DEPTH, DEC_BATCH, SSM_CONV - 1, SSM_XBC), f32),
        'w_ada': 0.3 * D_MODEL ** -0.5 * nrm(ks[7], (DEPTH, D_MODEL, N_MOD * D_MODEL), f32),
        'b_ada': 0.02 * nrm(ks[8], (DEPTH, N_MOD * D_MODEL), f32),
        'norm1_w': 1.0 + 0.02 * nrm(ks[9], (DEPTH, D_MODEL), f32),
        'w_in': D_MODEL ** -0.5 * nrm(ks[10], (DEPTH, D_MODEL, IN_COLS), f32),
        'hgrn_lower_bounds': 0.1 * nrm(ks[11], (DEPTH + 1, HG_KW), f32),
        'hgrn_norm_w': 1.0 + 0.02 * nrm(ks[12], (DEPTH, HG_WIDTH), f32),
        'conv_w': SSM_CONV ** -0.5 * nrm(ks[13], (DEPTH, SSM_CONV, SSM_XBC), f32),
        'conv_b': 0.02 * nrm(ks[15], (DEPTH, SSM_XBC), f32),
        'dt_bias': dt0 + jnp.log(-jnp.expm1(-dt0)),
        'a_log': jnp.log(jax.random.uniform(ks[16], (DEPTH, SSM_HEADS), minval=1.0, maxval=16.0)),
        'ssm_d': 1.0 + 0.02 * nrm(ks[17], (DEPTH, SSM_HEADS), f32),
        'ssm_norm_w': 1.0 + 0.02 * nrm(ks[18], (DEPTH, SSM_D_INNER), f32),
        'w_branch_a': HG_WIDTH ** -0.5 * nrm(ks[19], (DEPTH, HG_WIDTH, D_MODEL), f32),
        'w_branch_b': SSM_D_INNER ** -0.5 * nrm(ks[20], (DEPTH, SSM_D_INNER, D_MODEL), f32),
        'w_out': D_MODEL ** -0.5 * nrm(ks[21], (DEPTH, D_MODEL, D_MODEL), f32),
        'norm2_w': 1.0 + 0.02 * nrm(ks[22], (DEPTH, D_MODEL), f32),
        'peer_wq': D_MODEL ** -0.5 * nrm(ks[23], (DEPTH, D_MODEL, PEER_HEADS * PEER_DK), f32),
        'peer_keys1': PEER_DK_HALF ** -0.5 * nrm(ks[24], (DEPTH, PEER_HEADS, PEER_NKEYS, PEER_DK_HALF), f32),
        'peer_keys2': PEER_DK_HALF ** -0.5 * nrm(ks[25], (DEPTH, PEER_HEADS, PEER_NKEYS, PEER_DK_HALF), f32),
        'peer_u': D_MODEL ** -0.5 * nrm(ks[26], (DEPTH, PEER_EXPERTS, D_MODEL), f32),
        'peer_v': PEER_HEADS ** -0.5 * nrm(ks[27], (DEPTH, PEER_EXPERTS, D_MODEL), f32),
        'final_norm_w': 1.0 + 0.02 * nrm(ks[28], (D_MODEL,), f32),
    }


def reference(x_prompt, x_sample, c_prompt, c_sample, state_hgrn, state_ssm, state_conv,
              w_ada, b_ada, norm1_w, w_in, hgrn_lower_bounds, hgrn_norm_w, conv_w, conv_b,
              dt_bias, a_log, ssm_d, ssm_norm_w, w_branch_a, w_branch_b, w_out, norm2_w,
              peer_wq, peer_keys1, peer_keys2, peer_u, peer_v, final_norm_w):
    lb_all = jnp.cumsum(jax.nn.softmax(hgrn_lower_bounds.astype(jnp.float32), axis=0), axis=0)
    xp, xs = x_prompt, x_sample
    bp = x_prompt.shape[0]
    hg_p, ssm_p, conv_p, hg_s, ssm_s, conv_s = [], [], [], [], [], []
    for l in range(DEPTH):
        wl = (lb_all[l], w_ada[l], b_ada[l], norm1_w[l], w_in[l], hgrn_norm_w[l], conv_w[l], conv_b[l],
              dt_bias[l], a_log[l], ssm_d[l], ssm_norm_w[l], w_branch_a[l], w_branch_b[l], w_out[l],
              norm2_w[l], peer_wq[l], peer_keys1[l], peer_keys2[l], peer_u[l], peer_v[l])
        z_hg = jnp.zeros((bp, HG_HEADS, HG_DK, HG_DV), x_prompt.dtype)
        z_ssm = jnp.zeros((bp, SSM_HEADS, SSM_HEADDIM, SSM_STATE), x_prompt.dtype)
        z_conv = jnp.zeros((bp, SSM_CONV - 1, SSM_XBC), x_prompt.dtype)
        xp, a1, a2, a3 = _layer(xp, c_prompt, z_hg, z_ssm, z_conv, *wl)
        xs, b1, b2, b3 = _layer(xs, c_sample, state_hgrn[l], state_ssm[l], state_conv[l], *wl)
        hg_p.append(a1); ssm_p.append(a2); conv_p.append(a3)
        hg_s.append(b1); ssm_s.append(b2); conv_s.append(b3)
    y_prompt = (_rms(xp) * final_norm_w).astype(x_prompt.dtype)
    y_sample = (_rms(xs) * final_norm_w).astype(x_sample.dtype)
    hgrn_prompt = jnp.stack(hg_p)
    ssm_prompt = jnp.stack(ssm_p)
    conv_prompt = jnp.stack(conv_p)
    hgrn_sample = jnp.stack(hg_s)
    ssm_sample = jnp.stack(ssm_s)
    conv_sample = jnp.stack(conv_s)
    return (y_prompt, y_sample, hgrn_prompt, ssm_prompt, conv_prompt, hgrn_sample, ssm_sample, conv_sample)
```

```cpp
#include <hip/hip_runtime.h>
#include <hip/hip_cooperative_groups.h>
#include <hip/hip_fp16.h>
#include <cstdio>
namespace cg = cooperative_groups;

#define LAS __attribute__((address_space(3)))
typedef unsigned short bf16_t;
typedef short bf16x8 __attribute__((ext_vector_type(8)));
typedef float f32x4 __attribute__((ext_vector_type(4)));
typedef unsigned u32x4 __attribute__((ext_vector_type(4)));
typedef unsigned u32x2 __attribute__((ext_vector_type(2)));
typedef __bf16 bf2_t __attribute__((ext_vector_type(2)));

constexpr int NP = 65536, NS = 128, NR = NP + NS, MP = 65792;
constexpr int LDS_BYTES = 163840;

constexpr size_t WS_WHG = 0;
constexpr size_t WS_WSS = WS_WHG + (size_t)4096 * 1024 * 2;
constexpr size_t WS_WG  = WS_WSS + (size_t)5376 * 1024 * 2;
constexpr size_t WS_WA  = WS_WG + (size_t)2048 * 1024 * 2;
constexpr size_t WS_WB  = WS_WA + (size_t)1024 * 1024 * 2;
constexpr size_t WS_WO  = WS_WB + (size_t)1024 * 2048 * 2;
constexpr size_t WS_WQ  = WS_WO + (size_t)1024 * 1024 * 2;
constexpr size_t WS_K1  = WS_WQ + (size_t)2048 * 1024 * 2;
constexpr size_t WS_K2  = WS_K1 + (size_t)8 * 128 * 128 * 2;
constexpr size_t WS_U   = WS_K2 + (size_t)8 * 128 * 128 * 2;
constexpr size_t WS_V   = WS_U + (size_t)16384 * 1024 * 2;
constexpr size_t WS_MOD = WS_V + (size_t)16384 * 1024 * 2;
constexpr size_t WS_DT  = WS_MOD + (size_t)24 * 6144 * 4;
constexpr size_t WS_H   = WS_DT + (size_t)MP * 32 * 4;
constexpr size_t WS_P   = WS_H + (size_t)MP * 1024 * 2;
constexpr size_t WS_BAR = WS_P + (size_t)MP * 5120 * 2;
constexpr size_t WS_PB  = WS_BAR + 16384;
constexpr size_t WS_END = WS_PB + (size_t)MP * 1024 * 2;
constexpr size_t P_OBUF = (size_t)MP * 4096 * 2;
constexpr size_t P_X1   = 0;
constexpr size_t P_QB   = (size_t)MP * 1024 * 4;
constexpr size_t P_EIDX = P_QB + (size_t)MP * 2048 * 2;
constexpr size_t P_GW   = P_EIDX + (size_t)NR * 128 * 4;

constexpr size_t OFF_Y    = 0;
constexpr size_t OFF_HGP  = (size_t)NR * 1024;
constexpr size_t OFF_SSMP = OFF_HGP + (size_t)16 * 8 * 16384;
constexpr size_t OFF_CVP  = OFF_SSMP + (size_t)16 * 32 * 8192;
constexpr size_t OFF_HGS  = OFF_CVP + (size_t)16 * 3 * 3072;
constexpr size_t OFF_SSMS = OFF_HGS + (size_t)8 * 8 * 16384;
constexpr size_t OFF_CVS  = OFF_SSMS + (size_t)8 * 32 * 8192;

struct Params {
    const float* in[29];
    float* out;
    unsigned char* ws;
    int ph_lo, ph_hi;
};
enum { I_XP = 0, I_XS, I_CP, I_CS, I_SHG, I_SSSM, I_SCONV, I_WADA, I_BADA, I_N1W, I_WIN, I_LB, I_HGNW, I_CONVW, I_CONVB, I_DTB, I_ALOG, I_SSMD, I_SSMNW,
       I_WBA, I_WBB, I_WOUT, I_N2W, I_WQ, I_PK1, I_PK2, I_PU, I_PV, I_FNW };

__device__ __forceinline__ unsigned pk2(float lo, float hi) { unsigned r; asm("v_cvt_pk_bf16_f32 %0, %1, %2" : "=v"(r) : "v"(lo), "v"(hi)); return r; }
__device__ __forceinline__ bf16_t f2bf(float f) { return (bf16_t)(pk2(f, 0.f) & 0xFFFFu); }
__device__ __forceinline__ float bf2f(bf16_t b) { return __uint_as_float(((unsigned)b) << 16); }
__device__ __forceinline__ float bflo(unsigned u) { return __uint_as_float(u << 16); }
__device__ __forceinline__ float bfhi(unsigned u) { return __uint_as_float(u & 0xFFFF0000u); }
__device__ __forceinline__ float sigmoidf_(float x) { return 1.f / (1.f + __expf(-x)); }
__device__ __forceinline__ float siluf_(float x) { return x / (1.f + __expf(-x)); }
__device__ __forceinline__ int row_seq(int r) { return r < NP ? (r >> 12) : 16 + ((r - NP) >> 4); }
__device__ __forceinline__ float wave_sum(float v) {
#pragma unroll
    for (int d = 32; d >= 1; d >>= 1) v += __shfl_xor(v, d);
    return v;
}
__device__ __forceinline__ int otid() { int v; asm volatile("v_mov_b32 %0, %1" : "=v"(v) : "v"((int)threadIdx.x)); return v; }
__device__ __forceinline__ f32x4 mfma16(bf16x8 a, bf16x8 b, f32x4 c) { return __builtin_amdgcn_mfma_f32_16x16x32_bf16(a, b, c, 0, 0, 0); }
__device__ __forceinline__ bf16x8 as_bf8(u32x4 v) { return __builtin_bit_cast(bf16x8, v); }
#define LDS_DRAIN() asm volatile("s_waitcnt lgkmcnt(0)" ::: "memory")
#define LDS_DRAIN2(a, b) asm volatile("s_waitcnt lgkmcnt(0)" : "+v"(a), "+v"(b) :: "memory")
typedef short s16x4 __attribute__((ext_vector_type(4)));
__device__ __forceinline__ bf16x8 tr_frag(const LAS bf16_t* tile, int stride, int k0, int col0, int lane) {
    const int q = lane >> 4, a = (lane >> 2) & 3, b = lane & 3;
    const LAS bf16_t* p0 = tile + (k0 + 8 * q + a) * stride + col0 + 4 * b;
    const s16x4 r0 = __builtin_amdgcn_ds_read_tr16_b64_v4i16((LAS s16x4*)p0);
    const s16x4 r1 = __builtin_amdgcn_ds_read_tr16_b64_v4i16((LAS s16x4*)(p0 + 4 * stride));
    bf16x8 f; f[0] = r0[0]; f[1] = r0[1]; f[2] = r0[2]; f[3] = r0[3]; f[4] = r1[0]; f[5] = r1[1]; f[6] = r1[2]; f[7] = r1[3];
    return f;
}


#define XB_TMO      128
#define XB_XCNT(j)  (256  + 64 * (j))
#define XB_XSUB(j)  (1280 + 64 * (j))
#define XB_XGEN(j)  (2304 + 64 * (j))
#define XB_TOP      3328
#define XB_TOPGEN   3392
#define XCD_BAR_WORDS 3456
#define XB_SPIN_CAP (1u << 18)
__device__ __forceinline__ unsigned xb_ld(unsigned* p)              { return __hip_atomic_load(p, __ATOMIC_RELAXED, __HIP_MEMORY_SCOPE_AGENT); }
__device__ __forceinline__ unsigned xb_add(unsigned* p, unsigned v) { return __hip_atomic_fetch_add(p, v, __ATOMIC_RELAXED, __HIP_MEMORY_SCOPE_AGENT); }
__device__ __forceinline__ unsigned xb_xcc_id() { return (unsigned)__builtin_amdgcn_s_getreg((3 << 11) | 20) & 0xFu; }
#define XB_SPIN(cond, bar) do { unsigned _sp = 0; while (cond) { __builtin_amdgcn_s_sleep(1); \
    if ((++_sp & 255u) == 0u) { if (xb_ld(&(bar)[XB_TMO])) break; if (_sp > XB_SPIN_CAP) { atomicAdd(&(bar)[XB_TMO], 1u); break; } } } } while (0)
struct XcdBarrier { unsigned* bar; unsigned x; volatile LAS unsigned* st; };
__device__ __forceinline__ XcdBarrier xcd_barrier_post(unsigned* bar, volatile LAS unsigned* st) {
    XcdBarrier b; b.bar = bar; b.x = xb_xcc_id(); b.st = st;
    if (otid() == 0) (void)xb_add(&bar[XB_XCNT(b.x)], 1u);
    return b;
}
__device__ __forceinline__ void xcd_barrier_complete(unsigned* bar, unsigned x, unsigned& nloc, unsigned& nx) {
    const unsigned G = gridDim.x * gridDim.y * gridDim.z;
    unsigned sum, cnt, mine, sp = 0u;
    for (;;) {
        sum = 0u; cnt = 0u; mine = 0u;
#pragma unroll
        for (unsigned j = 0; j < 16; ++j) { const unsigned c = xb_ld(&bar[XB_XCNT(j)]); sum += c; cnt += (c > 0u) ? 1u : 0u; mine = (j == x) ? c : mine; }
        if (sum == G) break;
        __builtin_amdgcn_s_sleep(1);
        if ((++sp & 255u) == 0u) { if (xb_ld(&bar[XB_TMO])) break; if (sp > XB_SPIN_CAP) { atomicAdd(&bar[XB_TMO], 1u); break; } }
    }
    nloc = mine > 0u ? mine : 1u; nx = cnt > 0u ? cnt : 1u;
}
__device__ __forceinline__ void xcd_barrier(const XcdBarrier& b) {
    asm volatile("s_waitcnt vmcnt(0)" ::: "memory");
    __syncthreads();
    if (otid() == 0) {
        unsigned* bar = b.bar;
        __builtin_amdgcn_s_waitcnt(0);
        unsigned nloc = b.st[0], nx = b.st[1];
        if (nloc == 0u) { xcd_barrier_complete(bar, b.x, nloc, nx); b.st[0] = nloc; b.st[1] = nx; }
        const unsigned old = xb_add(&bar[XB_XSUB(b.x)], 1u);
        const unsigned gen = old / nloc;
        if (old + 1u == (gen + 1u) * nloc) {
            __builtin_amdgcn_fence(__ATOMIC_RELEASE, "agent");
            asm volatile("s_waitcnt vmcnt(0)" ::: "memory");
            const unsigned og = xb_add(&bar[XB_TOP], 1u);
            const unsigned tg = og / nx;
            if (og + 1u == (tg + 1u) * nx) xb_add(&bar[XB_TOPGEN], 1u);
            else XB_SPIN(xb_ld(&bar[XB_TOPGEN]) == tg, bar);
            __builtin_amdgcn_fence(__ATOMIC_ACQUIRE, "agent");
            xb_add(&bar[XB_XGEN(b.x)], 1u);
            asm volatile("s_waitcnt vmcnt(0)" ::: "memory");
        } else {
            XB_SPIN(xb_ld(&bar[XB_XGEN(b.x)]) == gen, bar);
            __builtin_amdgcn_fence(__ATOMIC_ACQUIRE, "agent");
            asm volatile("s_waitcnt vmcnt(0)" ::: "memory");
        }
    }
    __syncthreads();
}

__device__ void transpose_tile(const float* __restrict__ W, int N, int K, int k0, int n0, bf16_t* __restrict__ dst, int drow0, LAS float* tile) {
    const int t = otid();
#pragma unroll
    for (int i = 0; i < 2; ++i) {
        const int idx = t + 512 * i, row = idx >> 3, c4 = idx & 7;
        const float4 v = *(const float4*)(W + (size_t)(k0 + row) * N + n0 + c4 * 4);
        LAS float* d = tile + row * 33 + c4 * 4; d[0] = v.x; d[1] = v.y; d[2] = v.z; d[3] = v.w;
    }
    __syncthreads();
    const int n = t >> 4, kg = t & 15;
    float f[8];
#pragma unroll
    for (int e = 0; e < 8; ++e) f[e] = tile[(kg * 8 + e) * 33 + n];
    u32x4 o; o.x = pk2(f[0], f[1]); o.y = pk2(f[2], f[3]); o.z = pk2(f[4], f[5]); o.w = pk2(f[6], f[7]);
    *(u32x4*)(dst + (size_t)(drow0 + n) * K + k0 + kg * 8) = o;
    __syncthreads();
}

__device__ void cvt_bf16(const float* __restrict__ src, bf16_t* __restrict__ dst, size_t n8) {
    for (size_t i = (size_t)blockIdx.x * 512 + otid(); i < n8; i += (size_t)gridDim.x * 512) {
        const float4 a = *(const float4*)(src + i * 8), b = *(const float4*)(src + i * 8 + 4);
        u32x4 o; o.x = pk2(a.x, a.y); o.y = pk2(a.z, a.w); o.z = pk2(b.x, b.y); o.w = pk2(b.z, b.w);
        *(u32x4*)(dst + i * 8) = o;
    }
}

__device__ void cvt_fp8(const float* __restrict__ src, unsigned* __restrict__ dst, size_t n16, float scale) {
    for (size_t i = (size_t)blockIdx.x * 512 + otid(); i < n16; i += (size_t)gridDim.x * 512) {
        u32x4 o;
#pragma unroll
        for (int j = 0; j < 4; ++j) {
            const float4 a = *(const float4*)(src + i * 16 + j * 4);
            int pk = __builtin_amdgcn_cvt_pk_fp8_f32(a.x * scale, a.y * scale, 0, false);
            pk = __builtin_amdgcn_cvt_pk_fp8_f32(a.z * scale, a.w * scale, pk, true);
            o[j] = (unsigned)pk;
        }
        *(u32x4*)(dst + i * 4) = o;
    }
}

__device__ void prep_phase(const Params& p, LAS unsigned char* lds) {
    unsigned char* ws = p.ws;
    LAS float* tile = (LAS float*)lds;
    for (int job = blockIdx.x; job < 3848; job += gridDim.x) {
        if (job < 2824) {
            const int nt = job >> 3, kt = job & 7, n0 = nt * 32;
            bf16_t* dst; int drow0;
            if (n0 < 4096) { dst = (bf16_t*)(ws + WS_WHG); drow0 = n0; }
            else if (n0 < 9248) { dst = (bf16_t*)(ws + WS_WSS); drow0 = n0 - 4096; }
            else if (n0 < 10272) { const int c = n0 - 9248; dst = (bf16_t*)(ws + WS_WG); drow0 = (c >> 7) * 256 + (c & 127); }
            else { const int c = n0 - 10272; dst = (bf16_t*)(ws + WS_WG); drow0 = (c >> 7) * 256 + 128 + (c & 127); }
            transpose_tile(p.in[I_WIN], 11296, 1024, kt * 128, n0, dst, drow0, tile);
        } else if (job < 2824 + 256) {
            const int j = job - 2824; transpose_tile(p.in[I_WBA], 1024, 1024, (j & 7) * 128, (j >> 3) * 32, (bf16_t*)(ws + WS_WA), (j >> 3) * 32, tile);
        } else if (job < 2824 + 256 + 512) {
            const int j = job - 3080; transpose_tile(p.in[I_WBB], 1024, 2048, (j & 15) * 128, (j >> 4) * 32, (bf16_t*)(ws + WS_WB), (j >> 4) * 32, tile);
        } else if (job < 2824 + 256 + 512 + 256) {
            const int j = job - 3592; transpose_tile(p.in[I_WOUT], 1024, 1024, (j & 7) * 128, (j >> 3) * 32, (bf16_t*)(ws + WS_WO), (j >> 3) * 32, tile);
        }
    }
    __syncthreads();
    {
        LAS float* Ks = (LAS float*)lds;
        LAS float* Wsl = Ks + 128 * 129;
        for (int job = blockIdx.x; job < 256; job += gridDim.x) {
            const int t = otid(), pair = job >> 4, kt = job & 15, hh = pair >> 1, half = pair & 1;
            const float* ksrc = (half ? p.in[I_PK2] : p.in[I_PK1]) + (size_t)hh * 16384;
            const float* wsrc = p.in[I_WQ] + (size_t)(kt * 64) * 2048 + hh * 256 + half * 128;
#pragma unroll
            for (int i = 0; i < 8; ++i) { const int idx = t + 512 * i, key = idx >> 5, d4 = idx & 31; const float4 v = *(const float4*)(ksrc + key * 128 + d4 * 4);
                LAS float* d = Ks + key * 129 + d4 * 4; d[0] = v.x; d[1] = v.y; d[2] = v.z; d[3] = v.w; }
#pragma unroll
            for (int i = 0; i < 4; ++i) { const int idx = t + 512 * i, kk = idx >> 5, d4 = idx & 31; const float4 v = *(const float4*)(wsrc + (size_t)kk * 2048 + d4 * 4);
                LAS float* d = Wsl + kk * 129 + d4 * 4; d[0] = v.x; d[1] = v.y; d[2] = v.z; d[3] = v.w; }
            __syncthreads();
            const int kg = t >> 4, kq = t & 15;
            float acc[4][4];
#pragma unroll
            for (int i = 0; i < 4; ++i)
#pragma unroll
                for (int j = 0; j < 4; ++j) acc[i][j] = 0.f;
#pragma unroll 4
            for (int d = 0; d < 128; ++d) {
                float a[4], b[4];
#pragma unroll
                for (int i = 0; i < 4; ++i) { a[i] = Ks[(4 * kg + i) * 129 + d]; b[i] = Wsl[(4 * kq + i) * 129 + d]; }
#pragma unroll
                for (int i = 0; i < 4; ++i)
#pragma unroll
                    for (int j = 0; j < 4; ++j) acc[i][j] += a[i] * b[j];
            }
            bf16_t* dst = (bf16_t*)(ws + WS_WQ);
#pragma unroll
            for (int i = 0; i < 4; ++i) {
                u32x2 o; o.x = pk2(acc[i][0], acc[i][1]); o.y = pk2(acc[i][2], acc[i][3]);
                *(u32x2*)(dst + (size_t)(pair * 128 + 4 * kg + i) * 1024 + kt * 64 + 4 * kq) = o;
            }
            __syncthreads();
        }
    }
    cvt_fp8(p.in[I_PU], (unsigned*)(ws + WS_U), (size_t)16384 * 1024 / 16, 512.f);
    cvt_fp8(p.in[I_PV], (unsigned*)(ws + WS_V), (size_t)16384 * 1024 / 16, 32.f);
    __syncthreads();
    LAS float* sc = (LAS float*)lds;
    LAS float* red = sc + 24 * 1024;
    for (int job = blockIdx.x; job < 96; job += gridDim.x) {
        const int t = otid(), w = t >> 6, lane = t & 63;
        for (int i = t; i < 24 * 1024; i += 512) {
            const int s = i >> 10, k = i & 1023;
            const float cv = s < 16 ? p.in[I_CP][s * 1024 + k] : p.in[I_CS][(s - 16) * 1024 + k];
            sc[i] = siluf_(cv);
        }
        __syncthreads();
        const int col = job * 64 + lane;
        float acc[24];
#pragma unroll
        for (int s = 0; s < 24; ++s) acc[s] = 0.f;
        const float* wa = p.in[I_WADA];
        for (int k = w * 128; k < w * 128 + 128; k += 4) {
            const float w0 = wa[(size_t)k * 6144 + col], w1 = wa[(size_t)(k + 1) * 6144 + col], w2 = wa[(size_t)(k + 2) * 6144 + col], w3 = wa[(size_t)(k + 3) * 6144 + col];
#pragma unroll
            for (int s = 0; s < 24; ++s) { const f32x4 cv = *(LAS f32x4*)(sc + s * 1024 + k); acc[s] += cv[0] * w0 + cv[1] * w1 + cv[2] * w2 + cv[3] * w3; }
        }
#pragma unroll
        for (int s = 0; s < 24; ++s) red[(w * 24 + s) * 64 + lane] = acc[s];
        __syncthreads();
        for (int i = t; i < 24 * 64; i += 512) {
            const int s = i >> 6, l = i & 63; float v = 0.f;
#pragma unroll
            for (int ww = 0; ww < 8; ++ww) v += red[(ww * 24 + s) * 64 + l];
            ((float*)(ws + WS_MOD))[s * 6144 + job * 64 + l] = v + p.in[I_BADA][job * 64 + l];
        }
        __syncthreads();
    }
}

__device__ void norm_phase(const Params& p, int which) {
    const int t_ = otid(), w = t_ >> 6, lane = t_ & 63;
    const float* mod = (const float*)(p.ws + WS_MOD);
    bf16_t* H = (bf16_t*)(p.ws + WS_H);
    const float* x1 = (const float*)(p.ws + WS_P + P_X1);
    const float* nw = which == 0 ? p.in[I_N1W] : p.in[I_N2W];
    const int nwaves = gridDim.x * 8;
    for (int r0 = blockIdx.x * 8 + w; r0 < NR; r0 += nwaves * 4) {
        f32x4 v[4][4]; float ss[4];
#pragma unroll
        for (int k = 0; k < 4; ++k) {
            const int r = r0 + k * nwaves; const bool ok = r < NR; const int rr = ok ? r : r0;
            const float* xr = which == 0 ? (rr < NP ? p.in[I_XP] + (size_t)rr * 1024 : p.in[I_XS] + (size_t)(rr - NP) * 1024) : x1 + (size_t)rr * 1024;
#pragma unroll
            for (int i = 0; i < 4; ++i) v[k][i] = *(const f32x4*)(xr + lane * 4 + i * 256);
        }
#pragma unroll
        for (int k = 0; k < 4; ++k) {
            float s_ = 0.f;
#pragma unroll
            for (int i = 0; i < 4; ++i) s_ += v[k][i][0] * v[k][i][0] + v[k][i][1] * v[k][i][1] + v[k][i][2] * v[k][i][2] + v[k][i][3] * v[k][i][3];
            ss[k] = s_;
        }
#pragma unroll
        for (int d = 32; d >= 1; d >>= 1) {
#pragma unroll
            for (int k = 0; k < 4; ++k) ss[k] += __shfl_xor(ss[k], d);
        }
#pragma unroll
        for (int k = 0; k < 4; ++k) {
            const int r = r0 + k * nwaves;
            if (r < NR) {
                const float rs = rsqrtf(ss[k] * (1.f / 1024.f) + 1e-6f);
                const float* md = mod + row_seq(r) * 6144 + (which == 0 ? 0 : 3072);
#pragma unroll
                for (int i = 0; i < 4; ++i) {
                    const int c = lane * 4 + i * 256;
                    const f32x4 w4 = *(const f32x4*)(nw + c), sh = *(const f32x4*)(md + c), sc = *(const f32x4*)(md + 1024 + c);
                    f32x4 o;
#pragma unroll
                    for (int j = 0; j < 4; ++j) o[j] = v[k][i][j] * rs * w4[j] * (1.f + sc[j]) + sh[j];
                    u32x2 pk; pk.x = pk2(o[0], o[1]); pk.y = pk2(o[2], o[3]);
                    *(u32x2*)(H + (size_t)r * 1024 + c) = pk;
                }
            }
        }
    }
}

constexpr int BM = 256, BK = 64, HALF = 128, HTB = HALF * BK * 2, NXCD = 8, WGM = 8;
__device__ __forceinline__ int lds_byte(int r, int c) { const int st = (r >> 4) * 2 + (c >> 5), rr = r & 15, cc = c & 31, ob = rr * 64 + cc * 2; return st * 1024 + (ob ^ (((ob >> 9) & 1) << 5)); }
__device__ __forceinline__ void stage_rc(int b, int& R, int& C) { const int st = b / 1024, sb = b % 1024, swz = sb ^ (((sb >> 9) & 1) << 5); R = (st >> 1) * 16 + swz / 64; C = (st & 1) * 32 + (swz % 64) / 2; }
__device__ __forceinline__ int perm32(int rho) { const int n = rho >> 4, i = rho & 15; return 8 * (i >> 2) + 4 * n + (i & 3); }

struct Unit { int pm, pn; };
struct StaticOrder {
    int nM, nN, nwg, G, c, base, limit;
    __device__ void init(int M, int N, int G_, int c_) { nM = M / BM; nN = N / BM; nwg = nM * nN; G = G_; c = c_; base = 0; limit = nwg; }
    __device__ bool next(int i, Unit& u) const {
        const long L = (long)base + (long)i * G + c; if (L >= limit || L >= nwg) return false;
        int wgid = (int)L; { const int q = nwg / NXCD, r = nwg % NXCD, xcd = wgid % NXCD, off = wgid / NXCD; wgid = (xcd < r ? xcd * (q + 1) : r * (q + 1) + (xcd - r) * q) + off; }
        const int nig = WGM * nN, gid = wgid / nig, fm = gid * WGM, gsz = (nM - fm) < WGM ? (nM - fm) : WGM;
        u.pm = fm + ((wgid % nig) % gsz); u.pn = (wgid % nig) / gsz; return true;
    }
};

struct Epi {
    int mode;
    bf16_t* dst; int ldc;
    float* dt; const float* dt_bias;
    bf16_t* pa; const bf16_t* pb; int ldpb;
    const float* xp; const float* xs; const float* mod; float* x1;
    const float* lbp;
};

__device__ __forceinline__ void epilogue(const Epi& E, const f32x4 (&acc)[2][2][4][2], int pm, int pn, int wr, int wc, int fr, int fq) {
    const int row0 = pm * BM + wr * 64 + fr;
    if (E.mode == 4) {
        const int col0 = pn * BM + wc * 32 + 8 * fq;
        const int kind = pn >> 2;
        float lbv[2][8];
#pragma unroll
        for (int bj = 0; bj < 2; ++bj)
#pragma unroll
            for (int j = 0; j < 8; ++j) {
                const int cc = (col0 + bj * HALF + j) & 1023;
                lbv[bj][j] = kind == 1 ? 1.f / (1.f + __expf(E.lbp[1024 + cc] - E.lbp[cc])) : 0.f;
            }
#pragma unroll
        for (int ai = 0; ai < 2; ++ai)
#pragma unroll
            for (int m = 0; m < 4; ++m) {
                bf16_t* rowp = E.dst + (size_t)(row0 + ai * HALF + m * 16) * E.ldc + col0;
#pragma unroll
                for (int bj = 0; bj < 2; ++bj) {
                    float v[8];
#pragma unroll
                    for (int j = 0; j < 8; ++j) v[j] = acc[ai][bj][m][j >> 2][j & 3];
                    u32x4 wv;
                    if (kind == 1) {
#pragma unroll
                        for (int j = 0; j < 4; ++j) {
                            const float l0 = __logf(lbv[bj][2 * j] + (1.f - lbv[bj][2 * j]) * sigmoidf_(v[2 * j]));
                            const float l1 = __logf(lbv[bj][2 * j + 1] + (1.f - lbv[bj][2 * j + 1]) * sigmoidf_(v[2 * j + 1]));
                            wv[j] = (unsigned)__half_as_ushort(__float2half(l0)) | ((unsigned)__half_as_ushort(__float2half(l1)) << 16);
                        }
                    } else if (kind == 2) {
#pragma unroll
                        for (int j = 0; j < 4; ++j) wv[j] = pk2(v[2 * j], v[2 * j + 1]);
                    } else {
#pragma unroll
                        for (int j = 0; j < 4; ++j) wv[j] = pk2(siluf_(v[2 * j]), siluf_(v[2 * j + 1]));
                    }
                    *(u32x4*)(rowp + bj * HALF) = wv;
                }
            }
    } else if (E.mode == 5) {
        const int col0 = pn * BM + wc * 32 + 8 * fq;
#pragma unroll
        for (int ai = 0; ai < 2; ++ai)
#pragma unroll
            for (int m = 0; m < 4; ++m) {
                bf16_t* rowp = E.dst + (size_t)(row0 + ai * HALF + m * 16) * E.ldc + col0;
#pragma unroll
                for (int bj = 0; bj < 2; ++bj) {
                    const f32x4 v0 = acc[ai][bj][m][0], v1 = acc[ai][bj][m][1];
                    u32x4 w;
                    w.x = (unsigned)__half_as_ushort(__float2half(v0[0])) | ((unsigned)__half_as_ushort(__float2half(v0[1])) << 16);
                    w.y = (unsigned)__half_as_ushort(__float2half(v0[2])) | ((unsigned)__half_as_ushort(__float2half(v0[3])) << 16);
                    w.z = (unsigned)__half_as_ushort(__float2half(v1[0])) | ((unsigned)__half_as_ushort(__float2half(v1[1])) << 16);
                    w.w = (unsigned)__half_as_ushort(__float2half(v1[2])) | ((unsigned)__half_as_ushort(__float2half(v1[3])) << 16);
                    *(u32x4*)(rowp + bj * HALF) = w;
                }
            }
    } else if (E.mode == 0 || (E.mode == 1 && pn < 20)) {
        const int col0 = pn * BM + wc * 32 + 8 * fq;
#pragma unroll
        for (int ai = 0; ai < 2; ++ai)
#pragma unroll
            for (int m = 0; m < 4; ++m) {
                bf16_t* rowp = E.dst + (size_t)(row0 + ai * HALF + m * 16) * E.ldc + col0;
#pragma unroll
                for (int bj = 0; bj < 2; ++bj) {
                    const f32x4 v0 = acc[ai][bj][m][0], v1 = acc[ai][bj][m][1];
                    u32x4 w; w.x = pk2(v0[0], v0[1]); w.y = pk2(v0[2], v0[3]); w.z = pk2(v1[0], v1[1]); w.w = pk2(v1[2], v1[3]);
                    *(u32x4*)(rowp + bj * HALF) = w;
                }
            }
    } else if (E.mode == 1) {
        if (wc == 0) {
            const f32x4 b0 = *(const f32x4*)(E.dt_bias + 8 * fq), b1 = *(const f32x4*)(E.dt_bias + 8 * fq + 4);
#pragma unroll
            for (int ai = 0; ai < 2; ++ai)
#pragma unroll
                for (int m = 0; m < 4; ++m) {
                    const int r = row0 + ai * HALF + m * 16;
                    f32x4 o0, o1;
#pragma unroll
                    for (int j = 0; j < 4; ++j) {
                        const float a0 = acc[ai][0][m][0][j] + b0[j], a1 = acc[ai][0][m][1][j] + b1[j];
                        o0[j] = a0 > 20.f ? a0 : log1pf(__expf(a0)); o1[j] = a1 > 20.f ? a1 : log1pf(__expf(a1));
                    }
                    *(f32x4*)(E.dt + (size_t)r * 32 + 8 * fq) = o0; *(f32x4*)(E.dt + (size_t)r * 32 + 8 * fq + 4) = o1;
                }
        }
    } else if (E.mode == 2) {
        const int cm = pn * 128 + wc * 32 + 8 * fq;
#pragma unroll
        for (int ai = 0; ai < 2; ++ai)
#pragma unroll
            for (int m = 0; m < 4; ++m) {
                const int r = row0 + ai * HALF + m * 16;
                bf16_t* pap = E.pa + (size_t)r * 1024 + cm; const bf16_t* pbp = E.pb + (size_t)r * E.ldpb + cm;
                const u32x4 a = *(const u32x4*)pap, b = *(const u32x4*)pbp;
                float o[8];
#pragma unroll
                for (int j = 0; j < 8; ++j) {
                    const float ga = acc[ai][0][m][j >> 2][j & 3], gb = acc[ai][1][m][j >> 2][j & 3];
                    const float av = (j & 1) ? bfhi(a[j >> 1]) : bflo(a[j >> 1]), bv = (j & 1) ? bfhi(b[j >> 1]) : bflo(b[j >> 1]);
                    o[j] = sigmoidf_(ga) * av + sigmoidf_(gb) * bv;
                }
                u32x4 w; w.x = pk2(o[0], o[1]); w.y = pk2(o[2], o[3]); w.z = pk2(o[4], o[5]); w.w = pk2(o[6], o[7]);
                *(u32x4*)pap = w;
            }
    } else {
#pragma unroll
        for (int ai = 0; ai < 2; ++ai)
#pragma unroll
            for (int m = 0; m < 4; ++m) {
                const int r = row0 + ai * HALF + m * 16;
                if (r < NR) {
                    const float* xrow = r < NP ? E.xp + (size_t)r * 1024 : E.xs + (size_t)(r - NP) * 1024;
                    const float* g1 = E.mod + row_seq(r) * 6144 + 2048;
                    float* orow = E.x1 + (size_t)r * 1024;
#pragma unroll
                    for (int bj = 0; bj < 2; ++bj)
#pragma unroll
                        for (int n = 0; n < 2; ++n) {
                            const int c = pn * BM + bj * HALF + wc * 32 + n * 16 + 4 * fq;
                            const f32x4 xv = *(const f32x4*)(xrow + c), gv = *(const f32x4*)(g1 + c);
                            *(f32x4*)(orow + c) = xv + gv * acc[ai][bj][m][n];
                        }
                }
            }
    }
}

struct GemmArgs { const bf16_t* A; int lda; const bf16_t* Bt; int M, N, K; int oG, oC, oBase, oLimit; };

__device__ __forceinline__ void gemm_phase(LAS unsigned char* lds, const GemmArgs g, const Epi& E) {
    const int tid = otid(), wid = __builtin_amdgcn_readfirstlane(tid >> 6), lane = tid & 63, wr = wid >> 2, wc = wid & 3, fr = lane & 15, fq = lane >> 4;
    const int K = g.K, nt = K / BK, lda = g.lda;
    const bool perm = (E.mode != 3);
    StaticOrder S; S.init(g.M, g.N, g.oG, g.oC); S.base = g.oBase; S.limit = g.oLimit;
    unsigned voffA[2], voffB[2];
#pragma unroll
    for (int i = 0; i < 2; ++i) { int R, C; stage_rc(tid * 16 + i * 8192, R, C); const int Rb = perm ? ((R & ~31) + perm32(R & 31)) : R;
        voffA[i] = (unsigned)(R * lda + C) * 2u; voffB[i] = (unsigned)(Rb * K + C) * 2u; }
    const size_t kstep = (size_t)(BK * 2);
    const size_t hstepA = (size_t)HALF * lda * 2, hstepB = (size_t)HALF * K * 2;
    const size_t tstepA = 2 * hstepA, tstepB = 2 * hstepB;
    const unsigned ldsw = (unsigned)wid * 1024u;
    const int aoff = lds_byte(wr * 64 + fr, fq * 8), boff = lds_byte(wc * 32 + fr, fq * 8);
#define PG8_SA(b, h) (((b) * 2 + (h)) * HTB)
#define PG8_SB(b, h) ((4 + (b) * 2 + (h)) * HTB)
#define PG8_STAGE(bufoff, gbase, voff) do { _Pragma("unroll") for (int _i = 0; _i < 2; ++_i) \
        __builtin_amdgcn_global_load_lds((const unsigned*)((const char*)(gbase) + (voff)[_i]), (LAS unsigned*)(lds + (bufoff) + ldsw + _i * 8192), 16, 0, 0); } while (0)
#define PG8_LDA(dst, b, h) do { _Pragma("unroll") for (int m = 0; m < 4; ++m) _Pragma("unroll") for (int k = 0; k < 2; ++k) dst[m][k] = *(const LAS bf16x8*)(lds + PG8_SA(b, h) + aoff + m * 2048 + k * 1024); } while (0)
#define PG8_LDB(dst, b, h) do { _Pragma("unroll") for (int n = 0; n < 2; ++n) _Pragma("unroll") for (int k = 0; k < 2; ++k) dst[n][k] = *(const LAS bf16x8*)(lds + PG8_SB(b, h) + boff + n * 2048 + k * 1024); } while (0)
#define PG8_MMA(ai, bj, At, Bt) do { __builtin_amdgcn_s_setprio(1); _Pragma("unroll") for (int m = 0; m < 4; ++m) _Pragma("unroll") for (int n = 0; n < 2; ++n) _Pragma("unroll") for (int k = 0; k < 2; ++k) \
        acc[ai][bj][m][n] = __builtin_amdgcn_mfma_f32_16x16x32_bf16(Bt[n][k], At[m][k], acc[ai][bj][m][n], 0, 0, 0); __builtin_amdgcn_s_setprio(0); } while (0)
#define PG8_WAIT_V(n) asm volatile("s_waitcnt vmcnt(" #n ")" ::: "memory")
#define PG8_WAIT_L(n) asm volatile("s_waitcnt lgkmcnt(" #n ")" ::: "memory")
#define PG8_BAR __builtin_amdgcn_s_barrier()
#define PG8_SCHED __builtin_amdgcn_sched_barrier(0)
    Unit cur, nxt; int ui = 0;
    if (!S.next(0, cur)) return;
    f32x4 acc[2][2][4][2];
#pragma unroll
    for (int a = 0; a < 2; ++a)
#pragma unroll
        for (int b = 0; b < 2; ++b)
#pragma unroll
            for (int m = 0; m < 4; ++m)
#pragma unroll
                for (int n = 0; n < 2; ++n) acc[a][b][m][n] = (f32x4){0.f, 0.f, 0.f, 0.f};
    bf16x8 At[4][2], B0[2][2], B1[2][2];
    const char* cA = (const char*)g.A + (size_t)cur.pm * tstepA; const char* cB = (const char*)g.Bt + (size_t)cur.pn * tstepB;
    PG8_STAGE(PG8_SB(0, 0), cB, voffB); PG8_STAGE(PG8_SA(0, 0), cA, voffA); PG8_STAGE(PG8_SB(0, 1), cB + hstepB, voffB); PG8_STAGE(PG8_SA(0, 1), cA + hstepA, voffA);
    if (wr == 1) PG8_BAR;
    PG8_WAIT_V(4); PG8_BAR;
    PG8_STAGE(PG8_SB(1, 0), cB + kstep, voffB); PG8_STAGE(PG8_SA(1, 0), cA + kstep, voffA); PG8_STAGE(PG8_SB(1, 1), cB + hstepB + kstep, voffB);
    PG8_WAIT_V(6); PG8_BAR;
    for (;;) {
        const bool has_next = S.next(ui + 1, nxt);
        const char* nA = has_next ? (const char*)g.A + (size_t)nxt.pm * tstepA : cA; const char* nB = has_next ? (const char*)g.Bt + (size_t)nxt.pn * tstepB : cB;
        for (int t = 0; t < nt; t += 2) {
            const bool last = (t == nt - 2);
            const char* a1 = cA + (size_t)(t + 1) * kstep;
            const char* a2 = last ? nA : cA + (size_t)(t + 2) * kstep; const char* b2 = last ? nB : cB + (size_t)(t + 2) * kstep;
            const char* a3 = a2 + kstep; const char* b3 = b2 + kstep;
            PG8_LDB(B0, 0, 0); PG8_SCHED; PG8_LDA(At, 0, 0); PG8_STAGE(PG8_SA(1, 1), a1 + hstepA, voffA);
            PG8_WAIT_L(8); PG8_BAR; PG8_WAIT_L(0); PG8_MMA(0, 0, At, B0); PG8_BAR; PG8_SCHED;
            PG8_LDB(B1, 0, 1); PG8_STAGE(PG8_SB(0, 0), b2, voffB);
            PG8_BAR; PG8_WAIT_L(0); PG8_MMA(0, 1, At, B1); PG8_BAR;
            PG8_LDA(At, 0, 1); PG8_STAGE(PG8_SA(0, 0), a2, voffA);
            PG8_BAR; PG8_WAIT_L(0); PG8_MMA(1, 0, At, B0); PG8_BAR; PG8_SCHED;
            PG8_STAGE(PG8_SB(0, 1), b2 + hstepB, voffB);
            PG8_WAIT_V(6); PG8_BAR; PG8_MMA(1, 1, At, B1); PG8_BAR;
            PG8_LDB(B0, 1, 0); PG8_SCHED; PG8_LDA(At, 1, 0); PG8_STAGE(PG8_SA(0, 1), a2 + hstepA, voffA);
            PG8_WAIT_L(8); PG8_BAR; PG8_WAIT_L(0); PG8_MMA(0, 0, At, B0); PG8_BAR; PG8_SCHED;
            PG8_LDB(B1, 1, 1); PG8_STAGE(PG8_SB(1, 0), b3, voffB);
            PG8_BAR; PG8_WAIT_L(0); PG8_MMA(0, 1, At, B1); PG8_BAR;
            PG8_LDA(At, 1, 1); PG8_STAGE(PG8_SA(1, 0), a3, voffA);
            PG8_BAR; PG8_WAIT_L(0); PG8_MMA(1, 0, At, B0); PG8_BAR; PG8_SCHED;
            PG8_STAGE(PG8_SB(1, 1), b3 + hstepB, voffB);
            PG8_WAIT_V(6); PG8_BAR; PG8_MMA(1, 1, At, B1); PG8_BAR;
        }
        epilogue(E, acc, cur.pm, cur.pn, wr, wc, fr, fq);
        if (!has_next) break;
#pragma unroll
        for (int a = 0; a < 2; ++a)
#pragma unroll
            for (int b = 0; b < 2; ++b)
#pragma unroll
                for (int m = 0; m < 4; ++m)
#pragma unroll
                    for (int n = 0; n < 2; ++n) acc[a][b][m][n] = (f32x4){0.f, 0.f, 0.f, 0.f};
        cur = nxt; cA = nA; cB = nB; ++ui;
    }
    PG8_WAIT_V(0);
    if (wr == 0) PG8_BAR;
    PG8_BAR;
}


__device__ __forceinline__ void mini_epi(const Epi& E, int r, int col, float v, float v2) {
    if (E.mode == 0) {
        E.dst[(size_t)r * E.ldc + col] = f2bf(v);
    } else if (E.mode == 5) {
        E.dst[(size_t)r * E.ldc + col] = __half_as_ushort(__float2half(v));
    } else if (E.mode == 1) {
        if (col < 5120) E.dst[(size_t)r * E.ldc + col] = f2bf(v);
        else if (col < 5152) { const float a = v + E.dt_bias[col - 5120]; E.dt[(size_t)r * 32 + col - 5120] = a > 20.f ? a : log1pf(__expf(a)); }
    } else if (E.mode == 2) {
        bf16_t* pp = E.pa + (size_t)r * 1024 + col;
        *pp = f2bf(sigmoidf_(v) * bf2f(*pp) + sigmoidf_(v2) * bf2f(E.pb[(size_t)r * E.ldpb + col]));
    } else if (E.mode == 3) {
        E.x1[(size_t)r * 1024 + col] = E.xs[(size_t)(r - NP) * 1024 + col] + E.mod[row_seq(r) * 6144 + 2048 + col] * v;
    } else {
        const int kind = col >> 10, cc = col & 1023;
        bf16_t o;
        if (kind == 1) { const float lb = 1.f / (1.f + __expf(E.lbp[1024 + cc] - E.lbp[cc])); o = __half_as_ushort(__float2half(__logf(lb + (1.f - lb) * sigmoidf_(v)))); }
        else if (kind == 2) o = f2bf(v);
        else o = f2bf(siluf_(v));
        E.dst[(size_t)r * E.ldc + col] = o;
    }
}

__device__ void mini_gemm(const GemmArgs g, const Epi& E) {
    const int t = otid(), w = t >> 6, lane = t & 63, q = lane >> 4, c = lane & 15;
    const int K = g.K;
    const bf16_t* Arow = g.A + (size_t)(NP + 16 * w + c) * g.lda + 8 * q;
    const bool two = E.mode == 2;
    const int ntasks = two ? 64 : (E.mode == 1 ? 322 : g.N / 16);
    for (int task = blockIdx.x; task < ntasks; task += gridDim.x) {
        const int cm = task * 16 + c;
        const int brow0 = two ? ((cm >> 7) * 256 + (cm & 127)) : cm;
        const bf16_t* B0 = g.Bt + (size_t)brow0 * K + 8 * q;
        const bf16_t* B1 = B0 + (size_t)128 * K;
        f32x4 a0 = {0.f, 0.f, 0.f, 0.f}, a1 = {0.f, 0.f, 0.f, 0.f};
        if (two) {
#pragma unroll 4
            for (int ks = 0; ks < K / 32; ++ks) {
                const bf16x8 af = *(const bf16x8*)(Arow + 32 * ks);
                a0 = mfma16(af, *(const bf16x8*)(B0 + 32 * ks), a0);
                a1 = mfma16(af, *(const bf16x8*)(B1 + 32 * ks), a1);
            }
        } else {
#pragma unroll 8
            for (int ks = 0; ks < K / 32; ++ks) a0 = mfma16(*(const bf16x8*)(Arow + 32 * ks), *(const bf16x8*)(B0 + 32 * ks), a0);
        }
#pragma unroll
        for (int r = 0; r < 4; ++r) mini_epi(E, NP + 16 * w + 4 * q + r, cm, a0[r], a1[r]);
    }
}

__device__ __forceinline__ bf16_t elem16(const u32x4& v, int e) { return (bf16_t)((e & 1) ? (v[e >> 1] >> 16) : (v[e >> 1] & 0xFFFFu)); }

__device__ void gla_phase(const Params& p, LAS unsigned char* lds) {
    constexpr int SQ = 136, SJ = 72, SO = 132;
    LAS bf16_t* Qt = (LAS bf16_t*)lds;
    LAS bf16_t* Qh = Qt + 64 * SQ;
    LAS bf16_t* Kt = Qh + 64 * SQ;
    LAS bf16_t* Kh = Kt + 64 * SQ;
    LAS bf16_t* Vm = Kh + 64 * SQ;
    LAS bf16_t* Am = Vm + 64 * SQ;
    LAS float* Os = (LAS float*)(Am + 64 * SJ);
    LAS float* tot = Os + 64 * SO;
    LAS float* dk = tot + 512;
    LAS bf16_t* Rq = Am;
    LAS bf16_t* Rf = Rq + 64 * SQ;
    const int t = otid(), w = t >> 6, lane = t & 63, q = lane >> 4, c = lane & 15;
    const int ch = t & 127, rg = t >> 7;
    const int lr0 = t >> 4, lcg = t & 15, orow = t >> 3, ovs = (t & 7) * 16;
    const bf16_t* P = (const bf16_t*)(p.ws + WS_P);
    bf16_t* Ob = (bf16_t*)(p.ws + WS_P + P_OBUF);
    const u32x4 zero4 = {0u, 0u, 0u, 0u};
    for (int unit = blockIdx.x; unit < 192; unit += gridDim.x) {
        const int s = unit < 128 ? (unit >> 3) : 16 + ((unit - 128) >> 3), h = unit & 7;
        const int T = s < 16 ? 4096 : 16, row0 = s < 16 ? s * 4096 : NP + (s - 16) * 16;
        const int nch = (T + 63) >> 6;
        f32x4 S[8];
        float* sout = s < 16 ? p.out + OFF_HGP + (size_t)(s * 8 + h) * 16384 : p.out + OFF_HGS + (size_t)((s - 16) * 8 + h) * 16384;
        LAS float* St = (LAS float*)lds;
        if (s >= 16) {
            const float* sp = p.in[I_SHG] + (size_t)((s - 16) * 8 + h) * 16384;
#pragma unroll
            for (int i = 0; i < 8; ++i) { const int idx = t + 512 * i, kk = idx >> 5, v4 = idx & 31; *(LAS f32x4*)(St + kk * 132 + 4 * v4) = *(const f32x4*)(sp + kk * 128 + 4 * v4); }
            __syncthreads();
#pragma unroll
            for (int kt = 0; kt < 8; ++kt)
#pragma unroll
                for (int r = 0; r < 4; ++r) S[kt][r] = St[(16 * kt + 4 * q + r) * 132 + 16 * w + c];
        } else {
#pragma unroll
            for (int kt = 0; kt < 8; ++kt) S[kt] = (f32x4){0.f, 0.f, 0.f, 0.f};
        }
        u32x4 nq0, nq1, nf0, nf1, nv0, nv1, ng0, ng1;
#define GLA_LOAD(CHK) do { const int _l0 = (CHK) * 64; const size_t _rb = (size_t)row0 + _l0; \
            const bf16_t* _p0 = P + (_rb + lr0) * 4096 + h * 128 + 8 * lcg; const bf16_t* _p1 = _p0 + (size_t)32 * 4096; \
            const bool _ok0 = _l0 + lr0 < T, _ok1 = _l0 + lr0 + 32 < T; \
            nq0 = _ok0 ? *(const u32x4*)_p0 : zero4; nf0 = _ok0 ? *(const u32x4*)(_p0 + 1024) : zero4; nv0 = _ok0 ? *(const u32x4*)(_p0 + 2048) : zero4; \
            nq1 = _ok1 ? *(const u32x4*)_p1 : zero4; nf1 = _ok1 ? *(const u32x4*)(_p1 + 1024) : zero4; nv1 = _ok1 ? *(const u32x4*)(_p1 + 2048) : zero4; \
            const bf16_t* _pg = P + (_rb + orow) * 4096 + 3072 + h * 128 + ovs; const bool _okg = _l0 + orow < T; \
            ng0 = _okg ? *(const u32x4*)_pg : zero4; ng1 = _okg ? *(const u32x4*)(_pg + 8) : zero4; } while (0)
        GLA_LOAD(0);
        for (int chk = 0; chk < nch; ++chk) {
            const int rbase = row0 + chk * 64;
            const u32x4 cg0 = ng0, cg1 = ng1;
            *(LAS u32x4*)(Rq + lr0 * SQ + 8 * lcg) = nq0; *(LAS u32x4*)(Rq + (lr0 + 32) * SQ + 8 * lcg) = nq1;
            *(LAS u32x4*)(Rf + lr0 * SQ + 8 * lcg) = nf0; *(LAS u32x4*)(Rf + (lr0 + 32) * SQ + 8 * lcg) = nf1;
            *(LAS u32x4*)(Vm + lr0 * SQ + 8 * lcg) = nv0; *(LAS u32x4*)(Vm + (lr0 + 32) * SQ + 8 * lcg) = nv1;
            __syncthreads();
            float qf[16], kf[16], G[16];
            float run = 0.f;
#pragma unroll
            for (int e = 0; e < 16; ++e) {
                qf[e] = bf2f(Rq[(rg * 16 + e) * SQ + ch]);
                const float lf = __half2float(__ushort_as_half(Rf[(rg * 16 + e) * SQ + ch]));
                kf[e] = 1.f - __expf(lf);
                run += lf; G[e] = run;
            }
            tot[rg * 128 + ch] = run;
            __syncthreads();
            const float t0 = tot[ch], t1 = tot[128 + ch], t2 = tot[256 + ch], t3 = tot[384 + ch];
            const float off = rg == 0 ? 0.f : rg == 1 ? t0 : rg == 2 ? t0 + t1 : t0 + t1 + t2;
            const float Gm = t0 + t1, Gl = Gm + t2 + t3;
            if (rg == 0) dk[ch] = __expf(Gl);
            const float eGm = __expf(Gm), eGlm = __expf(Gl - Gm);
#pragma unroll
            for (int e = 0; e < 16; ++e) {
                const float g = off + G[e]; const int i = rg * 16 + e;
                const float e1 = __expf(g - Gm), e3 = __expf(Gm - g);
                Qt[i * SQ + ch] = f2bf(qf[e] * e1); Qh[i * SQ + ch] = f2bf(qf[e] * (e1 * eGm)); Kt[i * SQ + ch] = f2bf(kf[e] * e3);
                Kh[i * SQ + ch] = f2bf(kf[e] * (e3 * eGlm));
            }
            __syncthreads();
            if (chk + 1 < nch) GLA_LOAD(chk + 1);
            {
                const int jt = w >> 1;
#pragma unroll
                for (int u = 0; u < 2; ++u) {
                    const int it = 2 * (w & 1) + u; f32x4 a = {0.f, 0.f, 0.f, 0.f};
#pragma unroll
                    for (int ks = 0; ks < 4; ++ks) {
                        const bf16x8 af = *(const LAS bf16x8*)(Kt + (16 * jt + c) * SQ + 32 * ks + 8 * q);
                        const bf16x8 bf = *(const LAS bf16x8*)(Qt + (16 * it + c) * SQ + 32 * ks + 8 * q);
                        a = mfma16(af, bf, a);
                    }
                    const int i = 16 * it + c, j0 = 16 * jt + 4 * q;
                    u32x2 o; o.x = pk2(j0 <= i ? a[0] : 0.f, j0 + 1 <= i ? a[1] : 0.f); o.y = pk2(j0 + 2 <= i ? a[2] : 0.f, j0 + 3 <= i ? a[3] : 0.f);
                    *(LAS u32x2*)(Am + i * SJ + j0) = o;
                }
            }
            __syncthreads();
            {
                f32x4 O[4];
#pragma unroll
                for (int it = 0; it < 4; ++it) O[it] = (f32x4){0.f, 0.f, 0.f, 0.f};
                bf16x8 vf[2];
#pragma unroll
                for (int ks = 0; ks < 2; ++ks) vf[ks] = tr_frag(Vm, SQ, 32 * ks, 16 * w, lane);
                LDS_DRAIN2(vf[0], vf[1]);
#pragma unroll
                for (int it = 0; it < 4; ++it)
#pragma unroll
                    for (int ks = 0; ks < 2; ++ks) O[it] = mfma16(*(const LAS bf16x8*)(Am + (16 * it + c) * SJ + 32 * ks + 8 * q), vf[ks], O[it]);
#pragma unroll
                for (int ks = 0; ks < 4; ++ks) {
                    u32x4 sb; sb.x = pk2(S[2 * ks][0], S[2 * ks][1]); sb.y = pk2(S[2 * ks][2], S[2 * ks][3]); sb.z = pk2(S[2 * ks + 1][0], S[2 * ks + 1][1]); sb.w = pk2(S[2 * ks + 1][2], S[2 * ks + 1][3]);
#pragma unroll
                    for (int it = 0; it < 4; ++it) {
                        const u32x2 lo = *(const LAS u32x2*)(Qh + (16 * it + c) * SQ + 32 * ks + 4 * q), hi = *(const LAS u32x2*)(Qh + (16 * it + c) * SQ + 32 * ks + 16 + 4 * q);
                        u32x4 af; af.x = lo.x; af.y = lo.y; af.z = hi.x; af.w = hi.y;
                        O[it] = mfma16(as_bf8(af), as_bf8(sb), O[it]);
                    }
                }
#pragma unroll
                for (int it = 0; it < 4; ++it)
#pragma unroll
                    for (int r = 0; r < 4; ++r) Os[(16 * it + 4 * q + r) * SO + 16 * w + c] = O[it][r];
#pragma unroll
                for (int kt = 0; kt < 8; ++kt) {
                    const f32x4 d = *(const LAS f32x4*)(dk + 16 * kt + 4 * q);
                    S[kt] = S[kt] * d;
                    { bf16x8 af0 = tr_frag(Kh, SQ, 0, 16 * kt, lane), af1 = tr_frag(Kh, SQ, 32, 16 * kt, lane); LDS_DRAIN2(af0, af1);
                      S[kt] = mfma16(af0, vf[0], S[kt]); S[kt] = mfma16(af1, vf[1], S[kt]); }
                }
            }
            __syncthreads();
            {
                const int li = chk * 64 + orow;
                float x[16]; float ss = 0.f;
#pragma unroll
                for (int j = 0; j < 4; ++j) { const f32x4 v4 = *(const LAS f32x4*)(Os + orow * SO + ovs + 4 * j); x[4 * j] = v4[0]; x[4 * j + 1] = v4[1]; x[4 * j + 2] = v4[2]; x[4 * j + 3] = v4[3];
                    ss += v4[0] * v4[0] + v4[1] * v4[1] + v4[2] * v4[2] + v4[3] * v4[3]; }
                ss += __shfl_xor(ss, 1); ss += __shfl_xor(ss, 2); ss += __shfl_xor(ss, 4);
                const float rs = rsqrtf(ss * (1.f / 128.f) + 1e-6f);
                if (li < T) {
                    const size_t r = (size_t)rbase + orow;
                    const float* nw = p.in[I_HGNW] + h * 128 + ovs;
                    float o[16];
#pragma unroll
                    for (int e = 0; e < 16; ++e) {
                        const float gs = bf2f(e < 8 ? elem16(cg0, e) : elem16(cg1, e - 8));
                        o[e] = x[e] * rs * nw[e] * gs;
                    }
                    u32x4 w0, w1;
                    w0.x = pk2(o[0], o[1]); w0.y = pk2(o[2], o[3]); w0.z = pk2(o[4], o[5]); w0.w = pk2(o[6], o[7]);
                    w1.x = pk2(o[8], o[9]); w1.y = pk2(o[10], o[11]); w1.z = pk2(o[12], o[13]); w1.w = pk2(o[14], o[15]);
                    bf16_t* op = Ob + r * 1024 + h * 128 + ovs;
                    *(u32x4*)op = w0; *(u32x4*)(op + 8) = w1;
                }
            }
            __syncthreads();
        }
#undef GLA_LOAD
#pragma unroll
        for (int kt = 0; kt < 8; ++kt)
#pragma unroll
            for (int r = 0; r < 4; ++r) St[(16 * kt + 4 * q + r) * 132 + 16 * w + c] = S[kt][r];
        __syncthreads();
#pragma unroll
        for (int i = 0; i < 8; ++i) { const int idx = t + 512 * i, kk = idx >> 5, v4 = idx & 31; *(f32x4*)(sout + kk * 128 + 4 * v4) = *(const LAS f32x4*)(St + kk * 132 + 4 * v4); }
        __syncthreads();
    }
}

__device__ void conv_phase(const Params& p, const XcdBarrier& xb) {
    const int gt = blockIdx.x * 512 + otid();
    bf16_t* P = (bf16_t*)(p.ws + WS_P);
    const bool active = gt < 101376;
    int s = 0, row_start = 0, nrows = 0, cgp = 0; bool first = true, last_seg = false;
    if (gt < 98304) { cgp = gt % 384; const int sg = gt / 384; s = sg >> 4; const int seg = sg & 15; row_start = s * 4096 + seg * 256; nrows = 256; first = seg == 0; last_seg = seg == 15; }
    else if (active) { const int k = gt - 98304; cgp = k % 384; s = 16 + k / 384; row_start = NP + (s - 16) * 16; nrows = 16; first = true; last_seg = true; }
    const int ch0 = cgp * 8;
    float hx[3][8];
#pragma unroll
    for (int j = 0; j < 3; ++j)
#pragma unroll
        for (int c = 0; c < 8; ++c) hx[j][c] = 0.f;
    if (active) {
        if (!first) {
#pragma unroll
            for (int j = 0; j < 3; ++j) {
                const u32x4 v = *(const u32x4*)(P + (size_t)(row_start - 3 + j) * 5120 + 2048 + ch0);
#pragma unroll
                for (int c = 0; c < 4; ++c) { hx[j][2 * c] = bflo(v[c]); hx[j][2 * c + 1] = bfhi(v[c]); }
            }
        } else if (s >= 16) {
#pragma unroll
            for (int j = 0; j < 3; ++j) {
                const float* sp = p.in[I_SCONV] + (size_t)((s - 16) * 3 + j) * 3072 + ch0;
                const f32x4 a = *(const f32x4*)sp, b = *(const f32x4*)(sp + 4);
#pragma unroll
                for (int c = 0; c < 4; ++c) { hx[j][c] = a[c]; hx[j][4 + c] = b[c]; }
            }
        }
    }
    xcd_barrier(xb);
    if (active) {
        float w0[8], w1[8], w2[8], w3[8], cb[8];
#pragma unroll
        for (int c = 0; c < 8; ++c) { w0[c] = p.in[I_CONVW][ch0 + c]; w1[c] = p.in[I_CONVW][3072 + ch0 + c]; w2[c] = p.in[I_CONVW][6144 + ch0 + c]; w3[c] = p.in[I_CONVW][9216 + ch0 + c]; cb[c] = p.in[I_CONVB][ch0 + c]; }
        bf16_t* colp = P + (size_t)row_start * 5120 + 2048 + ch0;
#pragma unroll 1
        for (int r0 = 0; r0 < nrows; r0 += 8) {
            u32x4 raw[8];
#pragma unroll
            for (int i = 0; i < 8; ++i) raw[i] = *(const u32x4*)(colp + (size_t)(r0 + i) * 5120);
#pragma unroll
            for (int i = 0; i < 8; ++i) {
                float x[8], o[8];
#pragma unroll
                for (int c = 0; c < 4; ++c) { x[2 * c] = bflo(raw[i][c]); x[2 * c + 1] = bfhi(raw[i][c]); }
#pragma unroll
                for (int c = 0; c < 8; ++c) {
                    o[c] = siluf_(cb[c] + w0[c] * hx[0][c] + w1[c] * hx[1][c] + w2[c] * hx[2][c] + w3[c] * x[c]);
                    hx[0][c] = hx[1][c]; hx[1][c] = hx[2][c]; hx[2][c] = x[c];
                }
                u32x4 ov; ov.x = pk2(o[0], o[1]); ov.y = pk2(o[2], o[3]); ov.z = pk2(o[4], o[5]); ov.w = pk2(o[6], o[7]);
                *(u32x4*)(colp + (size_t)(r0 + i) * 5120) = ov;
            }
        }
        if (last_seg) {
            float* cp = s < 16 ? p.out + OFF_CVP + (size_t)s * 9216 : p.out + OFF_CVS + (size_t)(s - 16) * 9216;
#pragma unroll
            for (int j = 0; j < 3; ++j) {
                f32x4 a, b;
#pragma unroll
                for (int c = 0; c < 4; ++c) { a[c] = hx[j][c]; b[c] = hx[j][4 + c]; }
                *(f32x4*)(cp + j * 3072 + ch0) = a; *(f32x4*)(cp + j * 3072 + ch0 + 4) = b;
            }
        }
    }
}

__device__ void ssd_phase(const Params& p, LAS unsigned char* lds) {
    constexpr int SN = 136, SJ = 72, SY = 68;
    constexpr int HB_BYTES = (64 * SN + 3 * 64 * SJ) * 2 + 64 * SY * 4;
    LAS bf16_t* Bm = (LAS bf16_t*)lds;
    LAS bf16_t* Cm = Bm + 64 * SN;
    LAS unsigned char* hb0 = lds + 2 * 64 * SN * 2;
    LAS float* dsc = (LAS float*)(hb0 + 2 * HB_BYTES);
#define SSD_HT(hh) ((LAS bf16_t*)(hb0 + (hh) * HB_BYTES))
#define SSD_XS(hh) (SSD_HT(hh) + 64 * SN)
#define SSD_XH(hh) (SSD_XS(hh) + 64 * SJ)
#define SSD_WM(hh) (SSD_XH(hh) + 64 * SJ)
#define SSD_YS(hh) ((LAS float*)(SSD_WM(hh) + 64 * SJ))
#define SSD_DTV(hh) (dsc + (hh) * 256)
#define SSD_ACU(hh) (dsc + (hh) * 256 + 64)
#define SSD_WDV(hh) (dsc + (hh) * 256 + 128)
#define SSD_EAV(hh) (dsc + (hh) * 256 + 192)
    const int t = otid(), w = t >> 6, lane = t & 63, q = lane >> 4, c = lane & 15;
    const int lrow = t >> 4, lcg = t & 15, lhh = lcg >> 3, lcl = lcg & 7;
    const int mhh = w >> 2, mw = w & 3;
    bf16_t* P = (bf16_t*)(p.ws + WS_P);
    const float* DT = (const float*)(p.ws + WS_DT);
    const u32x4 zero4 = {0u, 0u, 0u, 0u};
    for (int unit = blockIdx.x; unit < 384; unit += gridDim.x) {
        const int uu = unit < 256 ? unit : unit - 256;
        const int s = (unit < 256 ? 0 : 16) + (uu >> 4), grp = (uu >> 2) & 3, h0 = grp * 8 + 2 * (uu & 3);
        const int T = s < 16 ? 4096 : 16, row0 = s < 16 ? s * 4096 : NP + (s - 16) * 16;
        const int nch = (T + 63) >> 6;
        const float a_neg = -__expf(p.in[I_ALOG][h0 + (w & 1)]);
        const float Dl = p.in[I_SSMD][h0 + lhh];
        f32x4 Hs[2][4];
        {
            const int hh_ = h0 + mhh;
            float* sout = s < 16 ? p.out + OFF_SSMP + (size_t)(s * 32 + hh_) * 8192 : p.out + OFF_SSMS + (size_t)((s - 16) * 32 + hh_) * 8192;
            (void)sout;
#pragma unroll
            for (int nn = 0; nn < 2; ++nn)
#pragma unroll
                for (int pt = 0; pt < 4; ++pt) {
                    const int nt = 2 * mw + nn;
                    if (s >= 16) Hs[nn][pt] = *(const f32x4*)(p.in[I_SSSM] + (size_t)((s - 16) * 32 + hh_) * 8192 + (16 * pt + c) * 128 + 16 * nt + 4 * q);
                    else Hs[nn][pt] = (f32x4){0.f, 0.f, 0.f, 0.f};
                    u32x2 o; o.x = pk2(Hs[nn][pt][0], Hs[nn][pt][1]); o.y = pk2(Hs[nn][pt][2], Hs[nn][pt][3]);
                    *(LAS u32x2*)(SSD_HT(mhh) + (16 * pt + c) * SN + 16 * nt + 4 * q) = o;
                }
        }
        u32x4 nx0, nx1, nz0, nz1, nb0, nb1, nc0, nc1; float ndt;
#define SSD_LOAD(CHK) do { const int _rb = row0 + (CHK) * 64; const int _l0 = (CHK) * 64; \
            const bf16_t* _r0 = P + (size_t)(_rb + lrow) * 5120; const bf16_t* _r1 = _r0 + (size_t)32 * 5120; \
            const bool _ok0 = _l0 + lrow < T, _ok1 = _l0 + lrow + 32 < T; \
            const int _xo = h0 * 64 + 8 * lcg, _bo = 4096 + grp * 128 + 8 * lcg; \
            nz0 = _ok0 ? *(const u32x4*)(_r0 + _xo) : zero4; nx0 = _ok0 ? *(const u32x4*)(_r0 + 2048 + _xo) : zero4; \
            nb0 = _ok0 ? *(const u32x4*)(_r0 + _bo) : zero4; nc0 = _ok0 ? *(const u32x4*)(_r0 + _bo + 512) : zero4; \
            nz1 = _ok1 ? *(const u32x4*)(_r1 + _xo) : zero4; nx1 = _ok1 ? *(const u32x4*)(_r1 + 2048 + _xo) : zero4; \
            nb1 = _ok1 ? *(const u32x4*)(_r1 + _bo) : zero4; nc1 = _ok1 ? *(const u32x4*)(_r1 + _bo + 512) : zero4; \
            ndt = (w < 2 && _l0 + lane < T) ? DT[(size_t)(_rb + lane) * 32 + h0 + w] : 0.f; } while (0)
        SSD_LOAD(0);
        for (int chk = 0; chk < nch; ++chk) {
            const int rbase = row0 + chk * 64;
            const u32x4 cx0 = nx0, cx1 = nx1, cz0 = nz0, cz1 = nz1, cb0 = nb0, cb1 = nb1, cc0 = nc0, cc1 = nc1; const float cdt = ndt;
            if (w < 2) {
                float ar = cdt * a_neg;
#pragma unroll
                for (int d = 1; d < 64; d <<= 1) { const float v = __shfl_up(ar, d); if (lane >= d) ar += v; }
                const float al = __shfl(ar, 63);
                SSD_DTV(w)[lane] = cdt; SSD_ACU(w)[lane] = ar; SSD_WDV(w)[lane] = __expf(al - ar) * cdt; SSD_EAV(w)[lane] = __expf(ar);
            }
            __syncthreads();
            {
                const float wd0 = SSD_WDV(lhh)[lrow], wd1 = SSD_WDV(lhh)[lrow + 32];
                u32x4 xh0, xh1;
#pragma unroll
                for (int j = 0; j < 4; ++j) { xh0[j] = pk2(bflo(cx0[j]) * wd0, bfhi(cx0[j]) * wd0); xh1[j] = pk2(bflo(cx1[j]) * wd1, bfhi(cx1[j]) * wd1); }
                *(LAS u32x4*)(SSD_XS(lhh) + lrow * SJ + 8 * lcl) = cx0; *(LAS u32x4*)(SSD_XS(lhh) + (lrow + 32) * SJ + 8 * lcl) = cx1;
                *(LAS u32x4*)(SSD_XH(lhh) + lrow * SJ + 8 * lcl) = xh0; *(LAS u32x4*)(SSD_XH(lhh) + (lrow + 32) * SJ + 8 * lcl) = xh1;
                *(LAS u32x4*)(Bm + lrow * SN + 8 * lcg) = cb0; *(LAS u32x4*)(Bm + (lrow + 32) * SN + 8 * lcg) = cb1;
                *(LAS u32x4*)(Cm + lrow * SN + 8 * lcg) = cc0; *(LAS u32x4*)(Cm + (lrow + 32) * SN + 8 * lcg) = cc1;
            }
            if (chk + 1 < nch) SSD_LOAD(chk + 1);
            __syncthreads();
            {
                const int jt = w >> 1;
#pragma unroll
                for (int u = 0; u < 2; ++u) {
                    const int it = 2 * (w & 1) + u; f32x4 a = {0.f, 0.f, 0.f, 0.f};
#pragma unroll
                    for (int ks = 0; ks < 4; ++ks) {
                        const bf16x8 af = *(const LAS bf16x8*)(Bm + (16 * jt + c) * SN + 32 * ks + 8 * q);
                        const bf16x8 bf = *(const LAS bf16x8*)(Cm + (16 * it + c) * SN + 32 * ks + 8 * q);
                        a = mfma16(af, bf, a);
                    }
                    const int i = 16 * it + c, j0 = 16 * jt + 4 * q;
#pragma unroll
                    for (int hh = 0; hh < 2; ++hh) {
                        const float ai = SSD_ACU(hh)[i];
                        float wv[4];
#pragma unroll
                        for (int r = 0; r < 4; ++r) { const int j = j0 + r; wv[r] = j <= i ? a[r] * __expf(ai - SSD_ACU(hh)[j]) * SSD_DTV(hh)[j] : 0.f; }
                        u32x2 o; o.x = pk2(wv[0], wv[1]); o.y = pk2(wv[2], wv[3]);
                        *(LAS u32x2*)(SSD_WM(hh) + i * SJ + j0) = o;
                    }
                }
            }
            __syncthreads();
            {
                const int it = mw;
                bf16x8 wf[2], cf[4];
#pragma unroll
                for (int ks = 0; ks < 2; ++ks) wf[ks] = *(const LAS bf16x8*)(SSD_WM(mhh) + (16 * it + c) * SJ + 32 * ks + 8 * q);
#pragma unroll
                for (int ks = 0; ks < 4; ++ks) cf[ks] = *(const LAS bf16x8*)(Cm + (16 * it + c) * SN + 32 * ks + 8 * q);
                const f32x4 ea = *(const LAS f32x4*)(SSD_EAV(mhh) + 16 * it + 4 * q);
#pragma unroll
                for (int pt = 0; pt < 4; ++pt) {
                    f32x4 Y1 = {0.f, 0.f, 0.f, 0.f}, Y2 = {0.f, 0.f, 0.f, 0.f};
                    { bf16x8 xf0 = tr_frag(SSD_XS(mhh), SJ, 0, 16 * pt, lane), xf1 = tr_frag(SSD_XS(mhh), SJ, 32, 16 * pt, lane); LDS_DRAIN2(xf0, xf1);
                      Y1 = mfma16(wf[0], xf0, Y1); Y1 = mfma16(wf[1], xf1, Y1); }
#pragma unroll
                    for (int ks = 0; ks < 4; ++ks) Y2 = mfma16(cf[ks], *(const LAS bf16x8*)(SSD_HT(mhh) + (16 * pt + c) * SN + 32 * ks + 8 * q), Y2);
#pragma unroll
                    for (int r = 0; r < 4; ++r) SSD_YS(mhh)[(16 * it + 4 * q + r) * SY + 16 * pt + c] = Y1[r] + ea[r] * Y2[r];
                }
            }
            {
                const float el = SSD_EAV(mhh)[63];
#pragma unroll
                for (int nn = 0; nn < 2; ++nn) {
                    const int nt = 2 * mw + nn;
                    bf16x8 bt[2];
#pragma unroll
                    for (int ks = 0; ks < 2; ++ks) bt[ks] = tr_frag(Bm, SN, 32 * ks, 16 * nt, lane);
                    LDS_DRAIN2(bt[0], bt[1]);
#pragma unroll
                    for (int pt = 0; pt < 4; ++pt) {
                        Hs[nn][pt] = Hs[nn][pt] * el;
                        { bf16x8 xf0 = tr_frag(SSD_XH(mhh), SJ, 0, 16 * pt, lane), xf1 = tr_frag(SSD_XH(mhh), SJ, 32, 16 * pt, lane); LDS_DRAIN2(xf0, xf1);
                          Hs[nn][pt] = mfma16(bt[0], xf0, Hs[nn][pt]); Hs[nn][pt] = mfma16(bt[1], xf1, Hs[nn][pt]); }
                    }
                }
            }
            __syncthreads();
#pragma unroll
            for (int nn = 0; nn < 2; ++nn)
#pragma unroll
                for (int pt = 0; pt < 4; ++pt) {
                    u32x2 o; o.x = pk2(Hs[nn][pt][0], Hs[nn][pt][1]); o.y = pk2(Hs[nn][pt][2], Hs[nn][pt][3]);
                    *(LAS u32x2*)(SSD_HT(mhh) + (16 * pt + c) * SN + 16 * (2 * mw + nn) + 4 * q) = o;
                }
#pragma unroll
            for (int hr = 0; hr < 2; ++hr) {
                const int rr = lrow + 32 * hr;
                if (chk * 64 + rr < T) {
                    const u32x4 xv = hr ? cx1 : cx0, zv = hr ? cz1 : cz0;
                    const f32x4 y0 = *(const LAS f32x4*)(SSD_YS(lhh) + rr * SY + 8 * lcl), y1 = *(const LAS f32x4*)(SSD_YS(lhh) + rr * SY + 8 * lcl + 4);
                    float o[8];
#pragma unroll
                    for (int e = 0; e < 8; ++e) {
                        const float y = (e < 4 ? y0[e & 3] : y1[e & 3]) + Dl * bf2f(elem16(xv, e));
                        o[e] = y * siluf_(bf2f(elem16(zv, e)));
                    }
                    u32x4 ov; ov.x = pk2(o[0], o[1]); ov.y = pk2(o[2], o[3]); ov.z = pk2(o[4], o[5]); ov.w = pk2(o[6], o[7]);
                    *(u32x4*)(P + (size_t)(rbase + rr) * 5120 + h0 * 64 + 8 * lcg) = ov;
                }
            }
        }
#undef SSD_LOAD
        {
            const int hh_ = h0 + mhh;
            float* sout = s < 16 ? p.out + OFF_SSMP + (size_t)(s * 32 + hh_) * 8192 : p.out + OFF_SSMS + (size_t)((s - 16) * 32 + hh_) * 8192;
#pragma unroll
            for (int nn = 0; nn < 2; ++nn)
#pragma unroll
                for (int pt = 0; pt < 4; ++pt) *(f32x4*)(sout + (16 * pt + c) * 128 + 16 * (2 * mw + nn) + 4 * q) = Hs[nn][pt];
        }
        __syncthreads();
    }
#undef SSD_HT
#undef SSD_XS
#undef SSD_XH
#undef SSD_WM
#undef SSD_YS
#undef SSD_DTV
#undef SSD_ACU
#undef SSD_WDV
#undef SSD_EAV
}

__device__ void ynorm_phase(const Params& p) {
    const int t_ = otid(), w = t_ >> 6, lane = t_ & 63;
    bf16_t* P = (bf16_t*)(p.ws + WS_P);
    bf16_t* YN = (bf16_t*)p.out;
    const int nwaves = gridDim.x * 8;
    for (int r0 = blockIdx.x * 8 + w; r0 < NR; r0 += nwaves * 2) {
        u32x4 v[2][4];
#pragma unroll
        for (int k = 0; k < 2; ++k) {
            const int r = r0 + k * nwaves; const int rr = r < NR ? r : r0;
#pragma unroll
            for (int g = 0; g < 4; ++g) v[k][g] = *(const u32x4*)(P + (size_t)rr * 5120 + g * 512 + lane * 8);
        }
        float ss[2][4];
#pragma unroll
        for (int k = 0; k < 2; ++k)
#pragma unroll
            for (int g = 0; g < 4; ++g) {
                float s_ = 0.f;
#pragma unroll
                for (int j = 0; j < 4; ++j) { const float a = bflo(v[k][g][j]), b = bfhi(v[k][g][j]); s_ += a * a + b * b; }
                ss[k][g] = s_;
            }
#pragma unroll
        for (int d = 32; d >= 1; d >>= 1) {
#pragma unroll
            for (int k = 0; k < 2; ++k)
#pragma unroll
                for (int g = 0; g < 4; ++g) ss[k][g] += __shfl_xor(ss[k][g], d);
        }
#pragma unroll
        for (int k = 0; k < 2; ++k) {
            const int r = r0 + k * nwaves;
            if (r < NR) {
#pragma unroll
                for (int g = 0; g < 4; ++g) {
                    const float rs = rsqrtf(ss[k][g] * (1.f / 512.f) + 1e-6f);
                    const float* nw = p.in[I_SSMNW] + g * 512 + lane * 8;
                    const f32x4 n0 = *(const f32x4*)nw, n1 = *(const f32x4*)(nw + 4);
                    u32x4 o;
                    o.x = pk2(bflo(v[k][g][0]) * rs * n0[0], bfhi(v[k][g][0]) * rs * n0[1]); o.y = pk2(bflo(v[k][g][1]) * rs * n0[2], bfhi(v[k][g][1]) * rs * n0[3]);
                    o.z = pk2(bflo(v[k][g][2]) * rs * n1[0], bfhi(v[k][g][2]) * rs * n1[1]); o.w = pk2(bflo(v[k][g][3]) * rs * n1[2], bfhi(v[k][g][3]) * rs * n1[3]);
                    *(u32x4*)(YN + (size_t)r * 2048 + g * 512 + lane * 8) = o;
                }
            }
        }
    }
}

__device__ __forceinline__ int f2key(float f) { const int b = __float_as_int(f); return b ^ ((b >> 31) & 0x7FFFFFFF); }
__device__ __forceinline__ float key2f(int k) { return __int_as_float(k ^ ((k >> 31) & 0x7FFFFFFF)); }
#define TOPK_INSERT(arr, x) do { int _x = (x); _Pragma("unroll") for (int _i = 0; _i < 16; ++_i) { const int _hi = max(arr[_i], _x); _x = min(arr[_i], _x); arr[_i] = _hi; } } while (0)

__constant__ unsigned char c_cand[52] = {
    0x00, 0x01, 0x02, 0x03, 0x04, 0x05, 0x06, 0x07, 0x08, 0x09, 0x0A, 0x0B, 0x0C, 0x0D, 0x0E, 0x0F,
    0x10, 0x11, 0x12, 0x13, 0x14, 0x15, 0x16, 0x17, 0x20, 0x21, 0x22, 0x23, 0x24, 0x30, 0x31, 0x32, 0x33,
    0x40, 0x41, 0x42, 0x50, 0x51, 0x60, 0x61, 0x70, 0x71, 0x80, 0x90, 0xA0, 0xB0, 0xC0, 0xD0, 0xE0, 0xF0, 0x00, 0x00};

__device__ __forceinline__ void merge16(int (&t)[16], int xr) {
    int b[16];
#pragma unroll
    for (int i = 0; i < 16; ++i) b[i] = __shfl_xor(t[15 - i], xr);
#pragma unroll
    for (int i = 0; i < 16; ++i) t[i] = max(t[i], b[i]);
#pragma unroll
    for (int s = 8; s >= 1; s >>= 1)
#pragma unroll
        for (int i = 0; i < 16; ++i)
            if ((i & s) == 0) { const int hi = max(t[i], t[i + s]), lo = min(t[i], t[i + s]); t[i] = hi; t[i + s] = lo; }
}

__device__ void route_phase(const Params& p, LAS unsigned char* lds) {
    const int t = otid(), w = t >> 6, lane = t & 63, q = lane >> 4, c = lane & 15;
    LAS float* sc = (LAS float*)(lds + w * 16640);
    LAS int* il = (LAS int*)sc;
    LAS float* vl = sc + 544;
    const bf16_t* Qb = (const bf16_t*)(p.ws + WS_P + P_QB);
    const bf16_t* K1 = (const bf16_t*)(p.ws + WS_K1); const bf16_t* K2 = (const bf16_t*)(p.ws + WS_K2);
    int* EIDX = (int*)(p.ws + WS_P + P_EIDX); float* GW = (float*)(p.ws + WS_P + P_GW);
    const int nunits = (NR / 16) * 8;
    const int tok = lane >> 2, hf = (lane >> 1) & 1, sub = lane & 1, cj = lane & 3;
    for (int u = blockIdx.x * 8 + w; u < nunits; u += gridDim.x * 8) {
        const int tg = u >> 3, h = u & 7, r0 = tg * 16;
        int top[16];
#pragma unroll
        for (int i = 0; i < 16; ++i) top[i] = (int)0x80000000;
        {
            const bf16_t* sp = Qb + (size_t)(r0 + tok) * 2048 + h * 256 + hf * 128 + sub * 64;
            u32x4 sv[8];
#pragma unroll
            for (int j8 = 0; j8 < 8; ++j8) sv[j8] = *(const u32x4*)(sp + 8 * j8);
#pragma unroll
            for (int j8 = 0; j8 < 8; ++j8)
#pragma unroll
                for (int e = 0; e < 8; ++e) {
                    const unsigned hw = (e & 1) ? (sv[j8][e >> 1] >> 16) : (sv[j8][e >> 1] & 0xFFFFu);
                    const float v = __half2float(__ushort_as_half((unsigned short)hw));
                    const int key = (f2key(v) & ~127) | (sub * 64 + 8 * j8 + e);
                    TOPK_INSERT(top, key);
                }
        }
        merge16(top, 1);
        asm volatile("s_waitcnt lgkmcnt(0)" ::: "memory");
        if (sub == 0) {
            const int lst = lane >> 1;
#pragma unroll
            for (int i = 0; i < 16; ++i) { il[lst * 17 + i] = top[i] & 127; vl[lst * 17 + i] = key2f(top[i] & ~127); }
        }
        asm volatile("s_waitcnt lgkmcnt(0)" ::: "memory");
        int ft[16];
#pragma unroll
        for (int i = 0; i < 16; ++i) ft[i] = (int)0x80000000;
#pragma unroll
        for (int m = 0; m < 13; ++m) {
            const int n = 4 * m + cj; const bool okc = n < 50;
            const int code = c_cand[okc ? n : 0];
            const float v = vl[(tok * 2) * 17 + (code >> 4)] + vl[(tok * 2 + 1) * 17 + (code & 15)];
            const int key = okc ? ((f2key(v) & ~255) | code) : (int)0x80000000;
            TOPK_INSERT(ft, key);
        }
        merge16(ft, 1); merge16(ft, 2);
        {
            float ev[16]; float sum = 0.f; const float mx = key2f(ft[0] & ~255);
#pragma unroll
            for (int i = 0; i < 16; ++i) { ev[i] = __expf(key2f(ft[i] & ~255) - mx); sum += ev[i]; }
            const float inv = 1.f / sum;
            if (cj == 0) {
                int ei[16];
#pragma unroll
                for (int i = 0; i < 16; ++i) { const int code = ft[i] & 255; ei[i] = il[(tok * 2) * 17 + (code >> 4)] * 128 + il[(tok * 2 + 1) * 17 + (code & 15)]; ev[i] *= inv; }
                int* ep = EIDX + ((size_t)(r0 + tok) * 8 + h) * 16; float* gp = GW + ((size_t)(r0 + tok) * 8 + h) * 16;
#pragma unroll
                for (int i = 0; i < 4; ++i) { *(int4*)(ep + 4 * i) = make_int4(ei[4 * i], ei[4 * i + 1], ei[4 * i + 2], ei[4 * i + 3]); *(float4*)(gp + 4 * i) = make_float4(ev[4 * i], ev[4 * i + 1], ev[4 * i + 2], ev[4 * i + 3]); }
            }
        }
        asm volatile("s_waitcnt lgkmcnt(0)" ::: "memory");
    }
}

typedef float f32x2 __attribute__((ext_vector_type(2)));
__device__ __forceinline__ void fp8x16_to_f32(const u32x4 q, float (&f)[16]) {
#pragma unroll
    for (int j = 0; j < 4; ++j) {
        const f32x2 lo = __builtin_amdgcn_cvt_pk_f32_fp8((int)q[j], false), hi = __builtin_amdgcn_cvt_pk_f32_fp8((int)q[j], true);
        f[4 * j] = lo.x; f[4 * j + 1] = lo.y; f[4 * j + 2] = hi.x; f[4 * j + 3] = hi.y;
    }
}

__device__ void expert_phase(const Params& p) {
    const int t_ = otid(), w = t_ >> 6, lane = t_ & 63;
    const bf16_t* H = (const bf16_t*)(p.ws + WS_H);
    const unsigned char* U8 = (const unsigned char*)(p.ws + WS_U); const unsigned char* V8 = (const unsigned char*)(p.ws + WS_V);
    const int* EIDX = (const int*)(p.ws + WS_P + P_EIDX); const float* GW = (const float*)(p.ws + WS_P + P_GW);
    const float* X1 = (const float*)(p.ws + WS_P + P_X1);
    const float* mod = (const float*)(p.ws + WS_MOD);
    const int xi = (lane >> 3) & 7;
    for (int r = blockIdx.x * 8 + w; r < NR; r += gridDim.x * 8) {
        const bf16_t* hr = H + (size_t)r * 1024 + lane * 16;
        const u32x4 ha = *(const u32x4*)hr, hb = *(const u32x4*)(hr + 8);
        float hf[16];
#pragma unroll
        for (int j = 0; j < 4; ++j) { hf[2 * j] = bflo(ha[j]); hf[2 * j + 1] = bfhi(ha[j]); hf[8 + 2 * j] = bflo(hb[j]); hf[8 + 2 * j + 1] = bfhi(hb[j]); }
        const int e0 = EIDX[(size_t)r * 128 + lane], e1 = EIDX[(size_t)r * 128 + 64 + lane];
        const float g0 = GW[(size_t)r * 128 + lane], g1 = GW[(size_t)r * 128 + 64 + lane];
        float out[16];
#pragma unroll
        for (int i = 0; i < 16; ++i) out[i] = 0.f;
#pragma unroll 1
        for (int jb = 0; jb < 16; ++jb) {
            const int esel = jb < 8 ? e0 : e1; const float gsel = jb < 8 ? g0 : g1;
            const int jbase = (jb * 8) & 63;
            u32x4 uq[8], vq[8];
#pragma unroll
            for (int x = 0; x < 8; ++x) {
                const int e = __builtin_amdgcn_readlane(esel, jbase + x);
                uq[x] = *(const u32x4*)(U8 + (size_t)e * 1024 + lane * 16);
                vq[x] = *(const u32x4*)(V8 + (size_t)e * 1024 + lane * 16);
            }
            const float glane = __shfl(gsel, jbase + xi);
            float d[8];
#pragma unroll
            for (int x = 0; x < 8; ++x) {
                float uf[16]; fp8x16_to_f32(uq[x], uf);
                float a = 0.f;
#pragma unroll
                for (int k = 0; k < 16; ++k) a += hf[k] * uf[k];
                d[x] = a;
            }
            float d4[4], d2[2], d1;
            {
                const bool up = (lane & 32) != 0;
#pragma unroll
                for (int i = 0; i < 4; ++i) { const float send = up ? d[i] : d[4 + i], keep = up ? d[4 + i] : d[i]; d4[i] = keep + __shfl_xor(send, 32); }
            }
            {
                const bool up = (lane & 16) != 0;
#pragma unroll
                for (int i = 0; i < 2; ++i) { const float send = up ? d4[i] : d4[2 + i], keep = up ? d4[2 + i] : d4[i]; d2[i] = keep + __shfl_xor(send, 16); }
            }
            {
                const bool up = (lane & 8) != 0;
                const float send = up ? d2[0] : d2[1], keep = up ? d2[1] : d2[0]; d1 = keep + __shfl_xor(send, 8);
            }
            d1 += __shfl_xor(d1, 4); d1 += __shfl_xor(d1, 2); d1 += __shfl_xor(d1, 1);
            const float a = d1 * (1.f / 512.f);
            const float cwl = 0.5f * a * (1.f + erff(a * 0.70710678118f)) * glane;
#pragma unroll
            for (int x = 0; x < 8; ++x) {
                const float cw = __int_as_float(__builtin_amdgcn_readlane(__float_as_int(cwl), 8 * x));
                float vf[16]; fp8x16_to_f32(vq[x], vf);
#pragma unroll
                for (int k = 0; k < 16; ++k) out[k] += cw * vf[k];
            }
        }
        const float* g2 = mod + row_seq(r) * 6144 + 5120;
        const float* xr = X1 + (size_t)r * 1024;
        float x2[16]; float ss = 0.f;
#pragma unroll
        for (int j4 = 0; j4 < 4; ++j4) {
            const int cc = lane * 16 + j4 * 4;
            const f32x4 xv = *(const f32x4*)(xr + cc), gv = *(const f32x4*)(g2 + cc);
#pragma unroll
            for (int j = 0; j < 4; ++j) { const float v = xv[j] + gv[j] * out[j4 * 4 + j] * (1.f / 32.f); x2[j4 * 4 + j] = v; ss += v * v; }
        }
        ss = wave_sum(ss);
        const float rs = rsqrtf(ss * (1.f / 1024.f) + 1e-6f);
#pragma unroll
        for (int j4 = 0; j4 < 4; ++j4) {
            const int cc = lane * 16 + j4 * 4;
            const f32x4 fw = *(const f32x4*)(p.in[I_FNW] + cc);
            f32x4 o;
#pragma unroll
            for (int j = 0; j < 4; ++j) o[j] = x2[j4 * 4 + j] * rs * fw[j];
            *(f32x4*)(p.out + OFF_Y + (size_t)r * 1024 + cc) = o;
        }
    }
}

constexpr int N_PHASES = 16;

__global__ __launch_bounds__(512, 2) void mega(Params p) {
    extern __shared__ __attribute__((aligned(16))) unsigned char shm[];
    LAS unsigned char* lds = (LAS unsigned char*)shm;
    cg::grid_group grid = cg::this_grid();
    volatile LAS unsigned* xst = (volatile LAS unsigned*)(lds + LDS_BYTES - 16);
    if (otid() == 0) { xst[0] = 0u; xst[1] = 0u; xst[2] = 0u; xst[3] = 0u; }
    __syncthreads();
    const XcdBarrier xb = xcd_barrier_post((unsigned*)(p.ws + WS_BAR), xst);
    unsigned char* ws = p.ws;
    bf16_t* Pb = (bf16_t*)(ws + WS_P);
    bf16_t* Hb = (bf16_t*)(ws + WS_H);
    bf16_t* PA = (bf16_t*)p.out;
    const bf16_t* YN = (const bf16_t*)p.out;
    bf16_t* PB2 = (bf16_t*)(ws + WS_PB);
    const int split_b = (int)gridDim.x > 128 ? 6 * ((int)gridDim.x - 128) : 0;
#ifdef REP_MASK
    bool rep_done = false;
#endif
    for (int ph = p.ph_lo; ph < p.ph_hi; ++ph) {
        GemmArgs g; Epi E; bool is_gemm = false;
        E.mode = 0; E.dst = nullptr; E.ldc = 0; E.dt = (float*)(ws + WS_DT); E.dt_bias = p.in[I_DTB]; E.pa = PA; E.pb = PB2; E.ldpb = 1024;
        E.lbp = p.in[I_LB]; E.xp = p.in[I_XP]; E.xs = p.in[I_XS]; E.mod = (const float*)(ws + WS_MOD); E.x1 = (float*)(ws + WS_P + P_X1);
        g.M = NP; g.lda = 1024; g.K = 1024; g.A = Hb; g.Bt = nullptr; g.N = 0; g.oG = (int)gridDim.x; g.oC = (int)blockIdx.x; g.oBase = 0; g.oLimit = 0x7fffffff;
        bool do_mini = true;
        switch (ph) {
            case 0: prep_phase(p, lds); break;
            case 1: norm_phase(p, 0); break;
            case 2: is_gemm = true; g.Bt = (const bf16_t*)(ws + WS_WSS); g.N = 5376; E.mode = 1; E.dst = Pb; E.ldc = 5120; break;
            case 3: conv_phase(p, xb); break;
            case 4: ssd_phase(p, lds); break;
            case 5: ynorm_phase(p); break;
            case 6: is_gemm = true; g.Bt = (const bf16_t*)(ws + WS_WHG); g.N = 4096; E.mode = 4; E.dst = Pb; E.ldc = 4096; break;
            case 7:
                if ((int)blockIdx.x < 192) gla_phase(p, lds);
                if ((int)blockIdx.x >= 128 && (int)gridDim.x > 128) {
                    is_gemm = true; do_mini = false; g.A = YN; g.lda = 2048; g.K = 2048; g.Bt = (const bf16_t*)(ws + WS_WB); g.N = 1024; E.mode = 0; E.dst = PB2; E.ldc = 1024;
                    g.oG = (int)gridDim.x - 128; g.oC = (int)blockIdx.x - 128; g.oBase = 0; g.oLimit = split_b;
                }
                break;
            case 8: is_gemm = true; g.A = YN; g.lda = 2048; g.K = 2048; g.Bt = (const bf16_t*)(ws + WS_WB); g.N = 1024; E.mode = 0; E.dst = PB2; E.ldc = 1024; g.oBase = split_b; break;
            case 9: is_gemm = true; g.A = (const bf16_t*)(ws + WS_P + P_OBUF); g.Bt = (const bf16_t*)(ws + WS_WA); g.N = 1024; E.mode = 0; E.dst = PA; E.ldc = 1024; break;
            case 10: is_gemm = true; g.Bt = (const bf16_t*)(ws + WS_WG); g.N = 2048; E.mode = 2; break;
            case 11: is_gemm = true; g.A = PA; g.Bt = (const bf16_t*)(ws + WS_WO); g.N = 1024; E.mode = 3; break;
            case 12: norm_phase(p, 1); break;
            case 13: is_gemm = true; g.Bt = (const bf16_t*)(ws + WS_WQ); g.N = 2048; E.mode = 5; E.dst = (bf16_t*)(ws + WS_P + P_QB); E.ldc = 2048; break;
            case 14: route_phase(p, lds); break;
            case 15: expert_phase(p); break;
            default: break;
        }
        if (is_gemm) { gemm_phase(lds, g, E); if (do_mini) mini_gemm(g, E); }
#ifdef REP_MASK
        if (((REP_MASK >> ph) & 1) && !rep_done) { rep_done = true; --ph; grid.sync(); continue; }
        rep_done = false;
#endif
        if (ph + 1 < p.ph_hi) { if (ph == 0) grid.sync(); else xcd_barrier(xb); }
    }
}

extern "C" void kernel_launch(void* const* d_in, const int* in_sizes, int n_in, void* d_out, int out_size, void* d_ws, size_t ws_size, hipStream_t stream) {
    static int grid_blocks = 0;
    if (grid_blocks == 0) {
        if (n_in != 29 || ws_size < WS_END) { fprintf(stderr, "kernel_launch: unexpected n_in %d / ws_size %zu (need %zu)\n", n_in, ws_size, (size_t)WS_END); grid_blocks = -1; return; }
        int dev = 0, cus = 0, per_cu = 0;
        hipGetDevice(&dev);
        hipDeviceGetAttribute(&cus, hipDeviceAttributeMultiprocessorCount, dev);
        if (hipFuncSetAttribute((const void*)mega, hipFuncAttributeMaxDynamicSharedMemorySize, LDS_BYTES) != hipSuccess) { fprintf(stderr, "kernel_launch: hipFuncSetAttribute failed\n"); }
        if (hipOccupancyMaxActiveBlocksPerMultiprocessor(&per_cu, (const void*)mega, 512, LDS_BYTES) != hipSuccess || per_cu < 1) { fprintf(stderr, "kernel_launch: occupancy query gave %d\n", per_cu); per_cu = 1; }
        (void)hipGetLastError();
        grid_blocks = cus * per_cu;
    }
    if (grid_blocks < 0) return;
    if (hipMemsetAsync((char*)d_ws + WS_BAR, 0, 16384, stream) != hipSuccess) { fprintf(stderr, "kernel_launch: memset of the barrier words failed\n"); return; }
    Params p{};
    for (int i = 0; i < 29; ++i) p.in[i] = (const float*)d_in[i];
    p.out = (float*)d_out; p.ws = (unsigned char*)d_ws;
#ifdef MULTI_LAUNCH
    for (int ph = 0; ph < N_PHASES; ++ph) {
        p.ph_lo = ph; p.ph_hi = ph + 1;
        hipLaunchKernelGGL(mega, dim3(grid_blocks), dim3(512), LDS_BYTES, stream, p);
    }
#else
    p.ph_lo = 0; p.ph_hi = N_PHASES;
    void* args[] = {&p};
    hipError_t e = hipLaunchCooperativeKernel((const void*)mega, dim3(grid_blocks), dim3(512), args, LDS_BYTES, stream);
    if (e != hipSuccess) fprintf(stderr, "cooperative launch failed: %s (grid %d)\n", hipGetErrorString(e), grid_blocks);
#endif
}
```

```cpp
#include <hip/hip_runtime.h>
#include <hip/hip_cooperative_groups.h>
#include <hip/hip_fp16.h>
#include <cstdio>
namespace cg = cooperative_groups;

#define LAS __attribute__((address_space(3)))
typedef unsigned short bf16_t;
typedef short bf16x8 __attribute__((ext_vector_type(8)));
typedef float f32x4 __attribute__((ext_vector_type(4)));
typedef unsigned u32x4 __attribute__((ext_vector_type(4)));
typedef unsigned u32x2 __attribute__((ext_vector_type(2)));
typedef __bf16 bf2_t __attribute__((ext_vector_type(2)));

constexpr int NP = 65536, NS = 128, NR = NP + NS, MP = 65792;
constexpr int LDS_BYTES = 163840;

constexpr size_t WS_WHG = 0;
constexpr size_t WS_WSS = WS_WHG + (size_t)4096 * 1024 * 2;
constexpr size_t WS_WG  = WS_WSS + (size_t)5376 * 1024 * 2;
constexpr size_t WS_WA  = WS_WG + (size_t)2048 * 1024 * 2;
constexpr size_t WS_WB  = WS_WA + (size_t)1024 * 1024 * 2;
constexpr size_t WS_WO  = WS_WB + (size_t)1024 * 2048 * 2;
constexpr size_t WS_WQ  = WS_WO + (size_t)1024 * 1024 * 2;
constexpr size_t WS_K1  = WS_WQ + (size_t)2048 * 1024 * 2;
constexpr size_t WS_K2  = WS_K1 + (size_t)8 * 128 * 128 * 2;
constexpr size_t WS_U   = WS_K2 + (size_t)8 * 128 * 128 * 2;
constexpr size_t WS_V   = WS_U + (size_t)16384 * 1024 * 2;
constexpr size_t WS_MOD = WS_V + (size_t)16384 * 1024 * 2;
constexpr size_t WS_DT  = WS_MOD + (size_t)24 * 6144 * 4;
constexpr size_t WS_H   = WS_DT + (size_t)MP * 32 * 4;
constexpr size_t WS_P   = WS_H + (size_t)MP * 1024 * 2;
constexpr size_t WS_BAR = WS_P + (size_t)MP * 5120 * 2;
constexpr size_t WS_PB  = WS_BAR + 16384;
constexpr size_t WS_END = WS_PB + (size_t)MP * 1024 * 2;
constexpr size_t P_OBUF = (size_t)MP * 4096 * 2;
constexpr size_t P_X1   = 0;
constexpr size_t P_QB   = (size_t)MP * 1024 * 4;
constexpr size_t P_EIDX = P_QB + (size_t)MP * 2048 * 2;
constexpr size_t P_GW   = P_EIDX + (size_t)NR * 128 * 4;

constexpr size_t OFF_Y    = 0;
constexpr size_t OFF_HGP  = (size_t)NR * 1024;
constexpr size_t OFF_SSMP = OFF_HGP + (size_t)16 * 8 * 16384;
constexpr size_t OFF_CVP  = OFF_SSMP + (size_t)16 * 32 * 8192;
constexpr size_t OFF_HGS  = OFF_CVP + (size_t)16 * 3 * 3072;
constexpr size_t OFF_SSMS = OFF_HGS + (size_t)8 * 8 * 16384;
constexpr size_t OFF_CVS  = OFF_SSMS + (size_t)8 * 32 * 8192;

struct Params {
    const float* in[29];
    float* out;
    unsigned char* ws;
    int ph_lo, ph_hi;
};
enum { I_XP = 0, I_XS, I_CP, I_CS, I_SHG, I_SSSM, I_SCONV, I_WADA, I_BADA, I_N1W, I_WIN, I_LB, I_HGNW, I_CONVW, I_CONVB, I_DTB, I_ALOG, I_SSMD, I_SSMNW,
       I_WBA, I_WBB, I_WOUT, I_N2W, I_WQ, I_PK1, I_PK2, I_PU, I_PV, I_FNW };

__device__ __forceinline__ unsigned pk2(float lo, float hi) { unsigned r; asm("v_cvt_pk_bf16_f32 %0, %1, %2" : "=v"(r) : "v"(lo), "v"(hi)); return r; }
__device__ __forceinline__ bf16_t f2bf(float f) { return (bf16_t)(pk2(f, 0.f) & 0xFFFFu); }
__device__ __forceinline__ float bf2f(bf16_t b) { return __uint_as_float(((unsigned)b) << 16); }
__device__ __forceinline__ float bflo(unsigned u) { return __uint_as_float(u << 16); }
__device__ __forceinline__ float bfhi(unsigned u) { return __uint_as_float(u & 0xFFFF0000u); }
__device__ __forceinline__ float sigmoidf_(float x) { return 1.f / (1.f + __expf(-x)); }
__device__ __forceinline__ float siluf_(float x) { return x / (1.f + __expf(-x)); }
__device__ __forceinline__ int row_seq(int r) { return r < NP ? (r >> 12) : 16 + ((r - NP) >> 4); }
__device__ __forceinline__ float wave_sum(float v) {
#pragma unroll
    for (int d = 32; d >= 1; d >>= 1) v += __shfl_xor(v, d);
    return v;
}
__device__ __forceinline__ int otid() { int v; asm volatile("v_mov_b32 %0, %1" : "=v"(v) : "v"((int)threadIdx.x)); return v; }
__device__ __forceinline__ f32x4 mfma16(bf16x8 a, bf16x8 b, f32x4 c) { return __builtin_amdgcn_mfma_f32_16x16x32_bf16(a, b, c, 0, 0, 0); }
__device__ __forceinline__ bf16x8 as_bf8(u32x4 v) { return __builtin_bit_cast(bf16x8, v); }
#define LDS_DRAIN() asm volatile("s_waitcnt lgkmcnt(0)" ::: "memory")
#define LDS_DRAIN2(a, b) asm volatile("s_waitcnt lgkmcnt(0)" : "+v"(a), "+v"(b) :: "memory")
typedef short s16x4 __attribute__((ext_vector_type(4)));
__device__ __forceinline__ bf16x8 tr_frag(const LAS bf16_t* tile, int stride, int k0, int col0, int lane) {
    const int q = lane >> 4, a = (lane >> 2) & 3, b = lane & 3;
    const LAS bf16_t* p0 = tile + (k0 + 8 * q + a) * stride + col0 + 4 * b;
    const s16x4 r0 = __builtin_amdgcn_ds_read_tr16_b64_v4i16((LAS s16x4*)p0);
    const s16x4 r1 = __builtin_amdgcn_ds_read_tr16_b64_v4i16((LAS s16x4*)(p0 + 4 * stride));
    bf16x8 f; f[0] = r0[0]; f[1] = r0[1]; f[2] = r0[2]; f[3] = r0[3]; f[4] = r1[0]; f[5] = r1[1]; f[6] = r1[2]; f[7] = r1[3];
    return f;
}


#define XB_TMO      128
#define XB_XCNT(j)  (256  + 64 * (j))
#define XB_XSUB(j)  (1280 + 64 * (j))
#define XB_XGEN(j)  (2304 + 64 * (j))
#define XB_TOP      3328
#define XB_TOPGEN   3392
#define XCD_BAR_WORDS 3456
#define XB_SPIN_CAP (1u << 18)
__device__ __forceinline__ unsigned xb_ld(unsigned* p)              { return __hip_atomic_load(p, __ATOMIC_RELAXED, __HIP_MEMORY_SCOPE_AGENT); }
__device__ __forceinline__ unsigned xb_add(unsigned* p, unsigned v) { return __hip_atomic_fetch_add(p, v, __ATOMIC_RELAXED, __HIP_MEMORY_SCOPE_AGENT); }
__device__ __forceinline__ unsigned xb_xcc_id() { return (unsigned)__builtin_amdgcn_s_getreg((3 << 11) | 20) & 0xFu; }
#define XB_SPIN(cond, bar) do { unsigned _sp = 0; while (cond) { __builtin_amdgcn_s_sleep(1); \
    if ((++_sp & 255u) == 0u) { if (xb_ld(&(bar)[XB_TMO])) break; if (_sp > XB_SPIN_CAP) { atomicAdd(&(bar)[XB_TMO], 1u); break; } } } } while (0)
struct XcdBarrier { unsigned* bar; unsigned x; volatile LAS unsigned* st; };
__device__ __forceinline__ XcdBarrier xcd_barrier_post(unsigned* bar, volatile LAS unsigned* st) {
    XcdBarrier b; b.bar = bar; b.x = xb_xcc_id(); b.st = st;
    if (otid() == 0) (void)xb_add(&bar[XB_XCNT(b.x)], 1u);
    return b;
}
__device__ __forceinline__ void xcd_barrier_complete(unsigned* bar, unsigned x, unsigned& nloc, unsigned& nx) {
    const unsigned G = gridDim.x * gridDim.y * gridDim.z;
    unsigned sum, cnt, mine, sp = 0u;
    for (;;) {
        sum = 0u; cnt = 0u; mine = 0u;
#pragma unroll
        for (unsigned j = 0; j < 16; ++j) { const unsigned c = xb_ld(&bar[XB_XCNT(j)]); sum += c; cnt += (c > 0u) ? 1u : 0u; mine = (j == x) ? c : mine; }
        if (sum == G) break;
        __builtin_amdgcn_s_sleep(1);
        if ((++sp & 255u) == 0u) { if (xb_ld(&bar[XB_TMO])) break; if (sp > XB_SPIN_CAP) { atomicAdd(&bar[XB_TMO], 1u); break; } }
    }
    nloc = mine > 0u ? mine : 1u; nx = cnt > 0u ? cnt : 1u;
}
__device__ __forceinline__ void xcd_barrier(const XcdBarrier& b) {
    asm volatile("s_waitcnt vmcnt(0)" ::: "memory");
    __syncthreads();
    if (otid() == 0) {
        unsigned* bar = b.bar;
        __builtin_amdgcn_s_waitcnt(0);
        unsigned nloc = b.st[0], nx = b.st[1];
        if (nloc == 0u) { xcd_barrier_complete(bar, b.x, nloc, nx); b.st[0] = nloc; b.st[1] = nx; }
        const unsigned old = xb_add(&bar[XB_XSUB(b.x)], 1u);
        const unsigned gen = old / nloc;
        if (old + 1u == (gen + 1u) * nloc) {
            __builtin_amdgcn_fence(__ATOMIC_RELEASE, "agent");
            asm volatile("s_waitcnt vmcnt(0)" ::: "memory");
            const unsigned og = xb_add(&bar[XB_TOP], 1u);
            const unsigned tg = og / nx;
            if (og + 1u == (tg + 1u) * nx) xb_add(&bar[XB_TOPGEN], 1u);
            else XB_SPIN(xb_ld(&bar[XB_TOPGEN]) == tg, bar);
            __builtin_amdgcn_fence(__ATOMIC_ACQUIRE, "agent");
            xb_add(&bar[XB_XGEN(b.x)], 1u);
            asm volatile("s_waitcnt vmcnt(0)" ::: "memory");
        } else {
            XB_SPIN(xb_ld(&bar[XB_XGEN(b.x)]) == gen, bar);
            __builtin_amdgcn_fence(__ATOMIC_ACQUIRE, "agent");
            asm volatile("s_waitcnt vmcnt(0)" ::: "memory");
        }
    }
    __syncthreads();
}

__device__ void transpose_tile(const float* __restrict__ W, int N, int K, int k0, int n0, bf16_t* __restrict__ dst, int drow0, LAS float* tile) {
    const int t = otid();
#pragma unroll
    for (int i = 0; i < 2; ++i) {
        const int idx = t + 512 * i, row = idx >> 3, c4 = idx & 7;
        const float4 v = *(const float4*)(W + (size_t)(k0 + row) * N + n0 + c4 * 4);
        LAS float* d = tile + row * 33 + c4 * 4; d[0] = v.x; d[1] = v.y; d[2] = v.z; d[3] = v.w;
    }
    __syncthreads();
    const int n = t >> 4, kg = t & 15;
    float f[8];
#pragma unroll
    for (int e = 0; e < 8; ++e) f[e] = tile[(kg * 8 + e) * 33 + n];
    u32x4 o; o.x = pk2(f[0], f[1]); o.y = pk2(f[2], f[3]); o.z = pk2(f[4], f[5]); o.w = pk2(f[6], f[7]);
    *(u32x4*)(dst + (size_t)(drow0 + n) * K + k0 + kg * 8) = o;
    __syncthreads();
}

__device__ void cvt_bf16(const float* __restrict__ src, bf16_t* __restrict__ dst, size_t n8) {
    for (size_t i = (size_t)blockIdx.x * 512 + otid(); i < n8; i += (size_t)gridDim.x * 512) {
        const float4 a = *(const float4*)(src + i * 8), b = *(const float4*)(src + i * 8 + 4);
        u32x4 o; o.x = pk2(a.x, a.y); o.y = pk2(a.z, a.w); o.z = pk2(b.x, b.y); o.w = pk2(b.z, b.w);
        *(u32x4*)(dst + i * 8) = o;
    }
}

__device__ void cvt_fp8(const float* __restrict__ src, unsigned* __restrict__ dst, size_t n16, float scale) {
    for (size_t i = (size_t)blockIdx.x * 512 + otid(); i < n16; i += (size_t)gridDim.x * 512) {
        u32x4 o;
#pragma unroll
        for (int j = 0; j < 4; ++j) {
            const float4 a = *(const float4*)(src + i * 16 + j * 4);
            int pk = __builtin_amdgcn_cvt_pk_fp8_f32(a.x * scale, a.y * scale, 0, false);
            pk = __builtin_amdgcn_cvt_pk_fp8_f32(a.z * scale, a.w * scale, pk, true);
            o[j] = (unsigned)pk;
        }
        *(u32x4*)(dst + i * 4) = o;
    }
}

__device__ void prep_phase(const Params& p, LAS unsigned char* lds) {
    unsigned char* ws = p.ws;
    LAS float* tile = (LAS float*)lds;
    for (int job = blockIdx.x; job < 3848; job += gridDim.x) {
        if (job < 2824) {
            const int nt = job >> 3, kt = job & 7, n0 = nt * 32;
            bf16_t* dst; int drow0;
            if (n0 < 4096) { dst = (bf16_t*)(ws + WS_WHG); drow0 = n0; }
            else if (n0 < 9248) { dst = (bf16_t*)(ws + WS_WSS); drow0 = n0 - 4096; }
            else if (n0 < 10272) { const int c = n0 - 9248; dst = (bf16_t*)(ws + WS_WG); drow0 = (c >> 7) * 256 + (c & 127); }
            else { const int c = n0 - 10272; dst = (bf16_t*)(ws + WS_WG); drow0 = (c >> 7) * 256 + 128 + (c & 127); }
            transpose_tile(p.in[I_WIN], 11296, 1024, kt * 128, n0, dst, drow0, tile);
        } else if (job < 2824 + 256) {
            const int j = job - 2824; transpose_tile(p.in[I_WBA], 1024, 1024, (j & 7) * 128, (j >> 3) * 32, (bf16_t*)(ws + WS_WA), (j >> 3) * 32, tile);
        } else if (job < 2824 + 256 + 512) {
            const int j = job - 3080; transpose_tile(p.in[I_WBB], 1024, 2048, (j & 15) * 128, (j >> 4) * 32, (bf16_t*)(ws + WS_WB), (j >> 4) * 32, tile);
        } else if (job < 2824 + 256 + 512 + 256) {
            const int j = job - 3592; transpose_tile(p.in[I_WOUT], 1024, 1024, (j & 7) * 128, (j >> 3) * 32, (bf16_t*)(ws + WS_WO), (j >> 3) * 32, tile);
        }
    }
    __syncthreads();
    {
        LAS float* Ks = (LAS float*)lds;
        LAS float* Wsl = Ks + 128 * 129;
        for (int job = blockIdx.x; job < 256; job += gridDim.x) {
            const int t = otid(), pair = job >> 4, kt = job & 15, hh = pair >> 1, half = pair & 1;
            const float* ksrc = (half ? p.in[I_PK2] : p.in[I_PK1]) + (size_t)hh * 16384;
            const float* wsrc = p.in[I_WQ] + (size_t)(kt * 64) * 2048 + hh * 256 + half * 128;
#pragma unroll
            for (int i = 0; i < 8; ++i) { const int idx = t + 512 * i, key = idx >> 5, d4 = idx & 31; const float4 v = *(const float4*)(ksrc + key * 128 + d4 * 4);
                LAS float* d = Ks + key * 129 + d4 * 4; d[0] = v.x; d[1] = v.y; d[2] = v.z; d[3] = v.w; }
#pragma unroll
            for (int i = 0; i < 4; ++i) { const int idx = t + 512 * i, kk = idx >> 5, d4 = idx & 31; const float4 v = *(const float4*)(wsrc + (size_t)kk * 2048 + d4 * 4);
                LAS float* d = Wsl + kk * 129 + d4 * 4; d[0] = v.x; d[1] = v.y; d[2] = v.z; d[3] = v.w; }
            __syncthreads();
            const int kg = t >> 4, kq = t & 15;
            float acc[4][4];
#pragma unroll
            for (int i = 0; i < 4; ++i)
#pragma unroll
                for (int j = 0; j < 4; ++j) acc[i][j] = 0.f;
#pragma unroll 4
            for (int d = 0; d < 128; ++d) {
                float a[4], b[4];
#pragma unroll
                for (int i = 0; i < 4; ++i) { a[i] = Ks[(4 * kg + i) * 129 + d]; b[i] = Wsl[(4 * kq + i) * 129 + d]; }
#pragma unroll
                for (int i = 0; i < 4; ++i)
#pragma unroll
                    for (int j = 0; j < 4; ++j) acc[i][j] += a[i] * b[j];
            }
            bf16_t* dst = (bf16_t*)(ws + WS_WQ);
#pragma unroll
            for (int i = 0; i < 4; ++i) {
                u32x2 o; o.x = pk2(acc[i][0], acc[i][1]); o.y = pk2(acc[i][2], acc[i][3]);
                *(u32x2*)(dst + (size_t)(pair * 128 + 4 * kg + i) * 1024 + kt * 64 + 4 * kq) = o;
            }
            __syncthreads();
        }
    }
    cvt_fp8(p.in[I_PU], (unsigned*)(ws + WS_U), (size_t)16384 * 1024 / 16, 512.f);
    cvt_fp8(p.in[I_PV], (unsigned*)(ws + WS_V), (size_t)16384 * 1024 / 16, 32.f);
    __syncthreads();
    LAS float* sc = (LAS float*)lds;
    LAS float* red = sc + 24 * 1024;
    for (int job = blockIdx.x; job < 96; job += gridDim.x) {
        const int t = otid(), w = t >> 6, lane = t & 63;
        for (int i = t; i < 24 * 1024; i += 512) {
            const int s = i >> 10, k = i & 1023;
            const float cv = s < 16 ? p.in[I_CP][s * 1024 + k] : p.in[I_CS][(s - 16) * 1024 + k];
            sc[i] = siluf_(cv);
        }
        __syncthreads();
        const int col = job * 64 + lane;
        float acc[24];
#pragma unroll
        for (int s = 0; s < 24; ++s) acc[s] = 0.f;
        const float* wa = p.in[I_WADA];
        for (int k = w * 128; k < w * 128 + 128; k += 4) {
            const float w0 = wa[(size_t)k * 6144 + col], w1 = wa[(size_t)(k + 1) * 6144 + col], w2 = wa[(size_t)(k + 2) * 6144 + col], w3 = wa[(size_t)(k + 3) * 6144 + col];
#pragma unroll
            for (int s = 0; s < 24; ++s) { const f32x4 cv = *(LAS f32x4*)(sc + s * 1024 + k); acc[s] += cv[0] * w0 + cv[1] * w1 + cv[2] * w2 + cv[3] * w3; }
        }
#pragma unroll
        for (int s = 0; s < 24; ++s) red[(w * 24 + s) * 64 + lane] = acc[s];
        __syncthreads();
        for (int i = t; i < 24 * 64; i += 512) {
            const int s = i >> 6, l = i & 63; float v = 0.f;
#pragma unroll
            for (int ww = 0; ww < 8; ++ww) v += red[(ww * 24 + s) * 64 + l];
            ((float*)(ws + WS_MOD))[s * 6144 + job * 64 + l] = v + p.in[I_BADA][job * 64 + l];
        }
        __syncthreads();
    }
}

__device__ void norm_phase(const Params& p, int which) {
    const int t_ = otid(), w = t_ >> 6, lane = t_ & 63;
    const float* mod = (const float*)(p.ws + WS_MOD);
    bf16_t* H = (bf16_t*)(p.ws + WS_H);
    const float* x1 = (const float*)(p.ws + WS_P + P_X1);
    const float* nw = which == 0 ? p.in[I_N1W] : p.in[I_N2W];
    const int nwaves = gridDim.x * 8;
    for (int r0 = blockIdx.x * 8 + w; r0 < NR; r0 += nwaves * 4) {
        f32x4 v[4][4]; float ss[4];
#pragma unroll
        for (int k = 0; k < 4; ++k) {
            const int r = r0 + k * nwaves; const bool ok = r < NR; const int rr = ok ? r : r0;
            const float* xr = which == 0 ? (rr < NP ? p.in[I_XP] + (size_t)rr * 1024 : p.in[I_XS] + (size_t)(rr - NP) * 1024) : x1 + (size_t)rr * 1024;
#pragma unroll
            for (int i = 0; i < 4; ++i) v[k][i] = *(const f32x4*)(xr + lane * 4 + i * 256);
        }
#pragma unroll
        for (int k = 0; k < 4; ++k) {
            float s_ = 0.f;
#pragma unroll
            for (int i = 0; i < 4; ++i) s_ += v[k][i][0] * v[k][i][0] + v[k][i][1] * v[k][i][1] + v[k][i][2] * v[k][i][2] + v[k][i][3] * v[k][i][3];
            ss[k] = s_;
        }
#pragma unroll
        for (int d = 32; d >= 1; d >>= 1) {
#pragma unroll
            for (int k = 0; k < 4; ++k) ss[k] += __shfl_xor(ss[k], d);
        }
#pragma unroll
        for (int k = 0; k < 4; ++k) {
            const int r = r0 + k * nwaves;
            if (r < NR) {
                const float rs = rsqrtf(ss[k] * (1.f / 1024.f) + 1e-6f);
                const float* md = mod + row_seq(r) * 6144 + (which == 0 ? 0 : 3072);
#pragma unroll
                for (int i = 0; i < 4; ++i) {
                    const int c = lane * 4 + i * 256;
                    const f32x4 w4 = *(const f32x4*)(nw + c), sh = *(const f32x4*)(md + c), sc = *(const f32x4*)(md + 1024 + c);
                    f32x4 o;
#pragma unroll
                    for (int j = 0; j < 4; ++j) o[j] = v[k][i][j] * rs * w4[j] * (1.f + sc[j]) + sh[j];
                    u32x2 pk; pk.x = pk2(o[0], o[1]); pk.y = pk2(o[2], o[3]);
                    *(u32x2*)(H + (size_t)r * 1024 + c) = pk;
                }
            }
        }
    }
}

constexpr int BM = 256, BK = 64, HALF = 128, HTB = HALF * BK * 2, NXCD = 8, WGM = 8;
__device__ __forceinline__ int lds_byte(int r, int c) { const int st = (r >> 4) * 2 + (c >> 5), rr = r & 15, cc = c & 31, ob = rr * 64 + cc * 2; return st * 1024 + (ob ^ (((ob >> 9) & 1) << 5)); }
__device__ __forceinline__ void stage_rc(int b, int& R, int& C) { const int st = b / 1024, sb = b % 1024, swz = sb ^ (((sb >> 9) & 1) << 5); R = (st >> 1) * 16 + swz / 64; C = (st & 1) * 32 + (swz % 64) / 2; }
__device__ __forceinline__ int perm32(int rho) { const int n = rho >> 4, i = rho & 15; return 8 * (i >> 2) + 4 * n + (i & 3); }

struct Unit { int pm, pn; };
struct StaticOrder {
    int nM, nN, nwg, G, c, base, limit;
    __device__ void init(int M, int N, int G_, int c_) { nM = M / BM; nN = N / BM; nwg = nM * nN; G = G_; c = c_; base = 0; limit = nwg; }
    __device__ bool next(int i, Unit& u) const {
        const long L = (long)base + (long)i * G + c; if (L >= limit || L >= nwg) return false;
        int wgid = (int)L; { const int q = nwg / NXCD, r = nwg % NXCD, xcd = wgid % NXCD, off = wgid / NXCD; wgid = (xcd < r ? xcd * (q + 1) : r * (q + 1) + (xcd - r) * q) + off; }
        const int nig = WGM * nN, gid = wgid / nig, fm = gid * WGM, gsz = (nM - fm) < WGM ? (nM - fm) : WGM;
        u.pm = fm + ((wgid % nig) % gsz); u.pn = (wgid % nig) / gsz; return true;
    }
};

struct Epi {
    int mode;
    bf16_t* dst; int ldc;
    float* dt; const float* dt_bias;
    bf16_t* pa; const bf16_t* pb; int ldpb;
    const float* xp; const float* xs; const float* mod; float* x1;
    const float* lbp;
};

__device__ __forceinline__ void epilogue(const Epi& E, const f32x4 (&acc)[2][2][4][2], int pm, int pn, int wr, int wc, int fr, int fq) {
    const int row0 = pm * BM + wr * 64 + fr;
    if (E.mode == 4) {
        const int col0 = pn * BM + wc * 32 + 8 * fq;
        const int kind = pn >> 2;
        float lbv[2][8];
#pragma unroll
        for (int bj = 0; bj < 2; ++bj)
#pragma unroll
            for (int j = 0; j < 8; ++j) {
                const int cc = (col0 + bj * HALF + j) & 1023;
                lbv[bj][j] = kind == 1 ? 1.f / (1.f + __expf(E.lbp[1024 + cc] - E.lbp[cc])) : 0.f;
            }
#pragma unroll
        for (int ai = 0; ai < 2; ++ai)
#pragma unroll
            for (int m = 0; m < 4; ++m) {
                bf16_t* rowp = E.dst + (size_t)(row0 + ai * HALF + m * 16) * E.ldc + col0;
#pragma unroll
                for (int bj = 0; bj < 2; ++bj) {
                    float v[8];
#pragma unroll
                    for (int j = 0; j < 8; ++j) v[j] = acc[ai][bj][m][j >> 2][j & 3];
                    u32x4 wv;
                    if (kind == 1) {
#pragma unroll
                        for (int j = 0; j < 4; ++j) {
                            const float l0 = __logf(lbv[bj][2 * j] + (1.f - lbv[bj][2 * j]) * sigmoidf_(v[2 * j]));
                            const float l1 = __logf(lbv[bj][2 * j + 1] + (1.f - lbv[bj][2 * j + 1]) * sigmoidf_(v[2 * j + 1]));
                            wv[j] = (unsigned)__half_as_ushort(__float2half(l0)) | ((unsigned)__half_as_ushort(__float2half(l1)) << 16);
                        }
                    } else if (kind == 2) {
#pragma unroll
                        for (int j = 0; j < 4; ++j) wv[j] = pk2(v[2 * j], v[2 * j + 1]);
                    } else {
#pragma unroll
                        for (int j = 0; j < 4; ++j) wv[j] = pk2(siluf_(v[2 * j]), siluf_(v[2 * j + 1]));
                    }
                    *(u32x4*)(rowp + bj * HALF) = wv;
                }
            }
    } else if (E.mode == 5) {
        const int col0 = pn * BM + wc * 32 + 8 * fq;
#pragma unroll
        for (int ai = 0; ai < 2; ++ai)
#pragma unroll
            for (int m = 0; m < 4; ++m) {
                bf16_t* rowp = E.dst + (size_t)(row0 + ai * HALF + m * 16) * E.ldc + col0;
#pragma unroll
                for (int bj = 0; bj < 2; ++bj) {
                    const f32x4 v0 = acc[ai][bj][m][0], v1 = acc[ai][bj][m][1];
                    u32x4 w;
                    w.x = (unsigned)__half_as_ushort(__float2half(v0[0])) | ((unsigned)__half_as_ushort(__float2half(v0[1])) << 16);
                    w.y = (unsigned)__half_as_ushort(__float2half(v0[2])) | ((unsigned)__half_as_ushort(__float2half(v0[3])) << 16);
                    w.z = (unsigned)__half_as_ushort(__float2half(v1[0])) | ((unsigned)__half_as_ushort(__float2half(v1[1])) << 16);
                    w.w = (unsigned)__half_as_ushort(__float2half(v1[2])) | ((unsigned)__half_as_ushort(__float2half(v1[3])) << 16);
                    *(u32x4*)(rowp + bj * HALF) = w;
                }
            }
    } else if (E.mode == 0 || (E.mode == 1 && pn < 20)) {
        const int col0 = pn * BM + wc * 32 + 8 * fq;
#pragma unroll
        for (int ai = 0; ai < 2; ++ai)
#pragma unroll
            for (int m = 0; m < 4; ++m) {
                bf16_t* rowp = E.dst + (size_t)(row0 + ai * HALF + m * 16) * E.ldc + col0;
#pragma unroll
                for (int bj = 0; bj < 2; ++bj) {
                    const f32x4 v0 = acc[ai][bj][m][0], v1 = acc[ai][bj][m][1];
                    u32x4 w; w.x = pk2(v0[0], v0[1]); w.y = pk2(v0[2], v0[3]); w.z = pk2(v1[0], v1[1]); w.w = pk2(v1[2], v1[3]);
                    *(u32x4*)(rowp + bj * HALF) = w;
                }
            }
    } else if (E.mode == 1) {
        if (wc == 0) {
            const f32x4 b0 = *(const f32x4*)(E.dt_bias + 8 * fq), b1 = *(const f32x4*)(E.dt_bias + 8 * fq + 4);
#pragma unroll
            for (int ai = 0; ai < 2; ++ai)
#pragma unroll
                for (int m = 0; m < 4; ++m) {
                    const int r = row0 + ai * HALF + m * 16;
                    f32x4 o0, o1;
#pragma unroll
                    for (int j = 0; j < 4; ++j) {
                        const float a0 = acc[ai][0][m][0][j] + b0[j], a1 = acc[ai][0][m][1][j] + b1[j];
                        o0[j] = a0 > 20.f ? a0 : log1pf(__expf(a0)); o1[j] = a1 > 20.f ? a1 : log1pf(__expf(a1));
                    }
                    *(f32x4*)(E.dt + (size_t)r * 32 + 8 * fq) = o0; *(f32x4*)(E.dt + (size_t)r * 32 + 8 * fq + 4) = o1;
                }
        }
    } else if (E.mode == 2) {
        const int cm = pn * 128 + wc * 32 + 8 * fq;
#pragma unroll
        for (int ai = 0; ai < 2; ++ai)
#pragma unroll
            for (int m = 0; m < 4; ++m) {
                const int r = row0 + ai * HALF + m * 16;
                bf16_t* pap = E.pa + (size_t)r * 1024 + cm; const bf16_t* pbp = E.pb + (size_t)r * E.ldpb + cm;
                const u32x4 a = *(const u32x4*)pap, b = *(const u32x4*)pbp;
                float o[8];
#pragma unroll
                for (int j = 0; j < 8; ++j) {
                    const float ga = acc[ai][0][m][j >> 2][j & 3], gb = acc[ai][1][m][j >> 2][j & 3];
                    const float av = (j & 1) ? bfhi(a[j >> 1]) : bflo(a[j >> 1]), bv = (j & 1) ? bfhi(b[j >> 1]) : bflo(b[j >> 1]);
                    o[j] = sigmoidf_(ga) * av + sigmoidf_(gb) * bv;
                }
                u32x4 w; w.x = pk2(o[0], o[1]); w.y = pk2(o[2], o[3]); w.z = pk2(o[4], o[5]); w.w = pk2(o[6], o[7]);
                *(u32x4*)pap = w;
            }
    } else {
#pragma unroll
        for (int ai = 0; ai < 2; ++ai)
#pragma unroll
            for (int m = 0; m < 4; ++m) {
                const int r = row0 + ai * HALF + m * 16;
                if (r < NR) {
                    const float* xrow = r < NP ? E.xp + (size_t)r * 1024 : E.xs + (size_t)(r - NP) * 1024;
                    const float* g1 = E.mod + row_seq(r) * 6144 + 2048;
                    float* orow = E.x1 + (size_t)r * 1024;
#pragma unroll
                    for (int bj = 0; bj < 2; ++bj)
#pragma unroll
                        for (int n = 0; n < 2; ++n) {
                            const int c = pn * BM + bj * HALF + wc * 32 + n * 16 + 4 * fq;
                            const f32x4 xv = *(const f32x4*)(xrow + c), gv = *(const f32x4*)(g1 + c);
                            *(f32x4*)(orow + c) = xv + gv * acc[ai][bj][m][n];
                        }
                }
            }
    }
}

struct GemmArgs { const bf16_t* A; int lda; const bf16_t* Bt; int M, N, K; int oG, oC, oBase, oLimit; };

__device__ __forceinline__ void gemm_phase(LAS unsigned char* lds, const GemmArgs g, const Epi& E) {
    const int tid = otid(), wid = __builtin_amdgcn_readfirstlane(tid >> 6), lane = tid & 63, wr = wid >> 2, wc = wid & 3, fr = lane & 15, fq = lane >> 4;
    const int K = g.K, nt = K / BK, lda = g.lda;
    const bool perm = (E.mode != 3);
    StaticOrder S; S.init(g.M, g.N, g.oG, g.oC); S.base = g.oBase; S.limit = g.oLimit;
    unsigned voffA[2], voffB[2];
#pragma unroll
    for (int i = 0; i < 2; ++i) { int R, C; stage_rc(tid * 16 + i * 8192, R, C); const int Rb = perm ? ((R & ~31) + perm32(R & 31)) : R;
        voffA[i] = (unsigned)(R * lda + C) * 2u; voffB[i] = (unsigned)(Rb * K + C) * 2u; }
    const size_t kstep = (size_t)(BK * 2);
    const size_t hstepA = (size_t)HALF * lda * 2, hstepB = (size_t)HALF * K * 2;
    const size_t tstepA = 2 * hstepA, tstepB = 2 * hstepB;
    const unsigned ldsw = (unsigned)wid * 1024u;
    const int aoff = lds_byte(wr * 64 + fr, fq * 8), boff = lds_byte(wc * 32 + fr, fq * 8);
#define PG8_SA(b, h) (((b) * 2 + (h)) * HTB)
#define PG8_SB(b, h) ((4 + (b) * 2 + (h)) * HTB)
#define PG8_STAGE(bufoff, gbase, voff) do { _Pragma("unroll") for (int _i = 0; _i < 2; ++_i) \
        __builtin_amdgcn_global_load_lds((const unsigned*)((const char*)(gbase) + (voff)[_i]), (LAS unsigned*)(lds + (bufoff) + ldsw + _i * 8192), 16, 0, 0); } while (0)
#define PG8_LDA(dst, b, h) do { _Pragma("unroll") for (int m = 0; m < 4; ++m) _Pragma("unroll") for (int k = 0; k < 2; ++k) dst[m][k] = *(const LAS bf16x8*)(lds + PG8_SA(b, h) + aoff + m * 2048 + k * 1024); } while (0)
#define PG8_LDB(dst, b, h) do { _Pragma("unroll") for (int n = 0; n < 2; ++n) _Pragma("unroll") for (int k = 0; k < 2; ++k) dst[n][k] = *(const LAS bf16x8*)(lds + PG8_SB(b, h) + boff + n * 2048 + k * 1024); } while (0)
#define PG8_MMA(ai, bj, At, Bt) do { __builtin_amdgcn_s_setprio(1); _Pragma("unroll") for (int m = 0; m < 4; ++m) _Pragma("unroll") for (int n = 0; n < 2; ++n) _Pragma("unroll") for (int k = 0; k < 2; ++k) \
        acc[ai][bj][m][n] = __builtin_amdgcn_mfma_f32_16x16x32_bf16(Bt[n][k], At[m][k], acc[ai][bj][m][n], 0, 0, 0); __builtin_amdgcn_s_setprio(0); } while (0)
#define PG8_WAIT_V(n) asm volatile("s_waitcnt vmcnt(" #n ")" ::: "memory")
#define PG8_WAIT_L(n) asm volatile("s_waitcnt lgkmcnt(" #n ")" ::: "memory")
#define PG8_BAR __builtin_amdgcn_s_barrier()
#define PG8_SCHED __builtin_amdgcn_sched_barrier(0)
    Unit cur, nxt; int ui = 0;
    if (!S.next(0, cur)) return;
    f32x4 acc[2][2][4][2];
#pragma unroll
    for (int a = 0; a < 2; ++a)
#pragma unroll
        for (int b = 0; b < 2; ++b)
#pragma unroll
            for (int m = 0; m < 4; ++m)
#pragma unroll
                for (int n = 0; n < 2; ++n) acc[a][b][m][n] = (f32x4){0.f, 0.f, 0.f, 0.f};
    bf16x8 At[4][2], B0[2][2], B1[2][2];
    const char* cA = (const char*)g.A + (size_t)cur.pm * tstepA; const char* cB = (const char*)g.Bt + (size_t)cur.pn * tstepB;
    PG8_STAGE(PG8_SB(0, 0), cB, voffB); PG8_STAGE(PG8_SA(0, 0), cA, voffA); PG8_STAGE(PG8_SB(0, 1), cB + hstepB, voffB); PG8_STAGE(PG8_SA(0, 1), cA + hstepA, voffA);
    if (wr == 1) PG8_BAR;
    PG8_WAIT_V(4); PG8_BAR;
    PG8_STAGE(PG8_SB(1, 0), cB + kstep, voffB); PG8_STAGE(PG8_SA(1, 0), cA + kstep, voffA); PG8_STAGE(PG8_SB(1, 1), cB + hstepB + kstep, voffB);
    PG8_WAIT_V(6); PG8_BAR;
    for (;;) {
        const bool has_next = S.next(ui + 1, nxt);
        const char* nA = has_next ? (const char*)g.A + (size_t)nxt.pm * tstepA : cA; const char* nB = has_next ? (const char*)g.Bt + (size_t)nxt.pn * tstepB : cB;
        for (int t = 0; t < nt; t += 2) {
            const bool last = (t == nt - 2);
            const char* a1 = cA + (size_t)(t + 1) * kstep;
            const char* a2 = last ? nA : cA + (size_t)(t + 2) * kstep; const char* b2 = last ? nB : cB + (size_t)(t + 2) * kstep;
            const char* a3 = a2 + kstep; const char* b3 = b2 + kstep;
            PG8_LDB(B0, 0, 0); PG8_SCHED; PG8_LDA(At, 0, 0); PG8_STAGE(PG8_SA(1, 1), a1 + hstepA, voffA);
            PG8_WAIT_L(8); PG8_BAR; PG8_WAIT_L(0); PG8_MMA(0, 0, At, B0); PG8_BAR; PG8_SCHED;
            PG8_LDB(B1, 0, 1); PG8_STAGE(PG8_SB(0, 0), b2, voffB);
            PG8_BAR; PG8_WAIT_L(0); PG8_MMA(0, 1, At, B1); PG8_BAR;
            PG8_LDA(At, 0, 1); PG8_STAGE(PG8_SA(0, 0), a2, voffA);
            PG8_BAR; PG8_WAIT_L(0); PG8_MMA(1, 0, At, B0); PG8_BAR; PG8_SCHED;
            PG8_STAGE(PG8_SB(0, 1), b2 + hstepB, voffB);
            PG8_WAIT_V(6); PG8_BAR; PG8_MMA(1, 1, At, B1); PG8_BAR;
            PG8_LDB(B0, 1, 0); PG8_SCHED; PG8_LDA(At, 1, 0); PG8_STAGE(PG8_SA(0, 1), a2 + hstepA, voffA);
            PG8_WAIT_L(8); PG8_BAR; PG8_WAIT_L(0); PG8_MMA(0, 0, At, B0); PG8_BAR; PG8_SCHED;
            PG8_LDB(B1, 1, 1); PG8_STAGE(PG8_SB(1, 0), b3, voffB);
            PG8_BAR; PG8_WAIT_L(0); PG8_MMA(0, 1, At, B1); PG8_BAR;
            PG8_LDA(At, 1, 1); PG8_STAGE(PG8_SA(1, 0), a3, voffA);
            PG8_BAR; PG8_WAIT_L(0); PG8_MMA(1, 0, At, B0); PG8_BAR; PG8_SCHED;
            PG8_STAGE(PG8_SB(1, 1), b3 + hstepB, voffB);
            PG8_WAIT_V(6); PG8_BAR; PG8_MMA(1, 1, At, B1); PG8_BAR;
        }
        epilogue(E, acc, cur.pm, cur.pn, wr, wc, fr, fq);
        if (!has_next) break;
#pragma unroll
        for (int a = 0; a < 2; ++a)
#pragma unroll
            for (int b = 0; b < 2; ++b)
#pragma unroll
                for (int m = 0; m < 4; ++m)
#pragma unroll
                    for (int n = 0; n < 2; ++n) acc[a][b][m][n] = (f32x4){0.f, 0.f, 0.f, 0.f};
        cur = nxt; cA = nA; cB = nB; ++ui;
    }
    PG8_WAIT_V(0);
    if (wr == 0) PG8_BAR;
    PG8_BAR;
}


__device__ __forceinline__ void mini_epi(const Epi& E, int r, int col, float v, float v2) {
    if (E.mode == 0) {
        E.dst[(size_t)r * E.ldc + col] = f2bf(v);
    } else if (E.mode == 5) {
        E.dst[(size_t)r * E.ldc + col] = __half_as_ushort(__float2half(v));
    } else if (E.mode == 1) {
        if (col < 5120) E.dst[(size_t)r * E.ldc + col] = f2bf(v);
        else if (col < 5152) { const float a = v + E.dt_bias[col - 5120]; E.dt[(size_t)r * 32 + col - 5120] = a > 20.f ? a : log1pf(__expf(a)); }
    } else if (E.mode == 2) {
        bf16_t* pp = E.pa + (size_t)r * 1024 + col;
        *pp = f2bf(sigmoidf_(v) * bf2f(*pp) + sigmoidf_(v2) * bf2f(E.pb[(size_t)r * E.ldpb + col]));
    } else if (E.mode == 3) {
        E.x1[(size_t)r * 1024 + col] = E.xs[(size_t)(r - NP) * 1024 + col] + E.mod[row_seq(r) * 6144 + 2048 + col] * v;
    } else {
        const int kind = col >> 10, cc = col & 1023;
        bf16_t o;
        if (kind == 1) { const float lb = 1.f / (1.f + __expf(E.lbp[1024 + cc] - E.lbp[cc])); o = __half_as_ushort(__float2half(__logf(lb + (1.f - lb) * sigmoidf_(v)))); }
        else if (kind == 2) o = f2bf(v);
        else o = f2bf(siluf_(v));
        E.dst[(size_t)r * E.ldc + col] = o;
    }
}

__device__ void mini_gemm(const GemmArgs g, const Epi& E) {
    const int t = otid(), w = t >> 6, lane = t & 63, q = lane >> 4, c = lane & 15;
    const int K = g.K;
    const bf16_t* Arow = g.A + (size_t)(NP + 16 * w + c) * g.lda + 8 * q;
    const bool two = E.mode == 2;
    const int ntasks = two ? 64 : (E.mode == 1 ? 322 : g.N / 16);
    for (int task = blockIdx.x; task < ntasks; task += gridDim.x) {
        const int cm = task * 16 + c;
        const int brow0 = two ? ((cm >> 7) * 256 + (cm & 127)) : cm;
        const bf16_t* B0 = g.Bt + (size_t)brow0 * K + 8 * q;
        const bf16_t* B1 = B0 + (size_t)128 * K;
        f32x4 a0 = {0.f, 0.f, 0.f, 0.f}, a1 = {0.f, 0.f, 0.f, 0.f};
        if (two) {
#pragma unroll 4
            for (int ks = 0; ks < K / 32; ++ks) {
                const bf16x8 af = *(const bf16x8*)(Arow + 32 * ks);
                a0 = mfma16(af, *(const bf16x8*)(B0 + 32 * ks), a0);
                a1 = mfma16(af, *(const bf16x8*)(B1 + 32 * ks), a1);
            }
        } else {
#pragma unroll 8
            for (int ks = 0; ks < K / 32; ++ks) a0 = mfma16(*(const bf16x8*)(Arow + 32 * ks), *(const bf16x8*)(B0 + 32 * ks), a0);
        }
#pragma unroll
        for (int r = 0; r < 4; ++r) mini_epi(E, NP + 16 * w + 4 * q + r, cm, a0[r], a1[r]);
    }
}

__device__ __forceinline__ bf16_t elem16(const u32x4& v, int e) { return (bf16_t)((e & 1) ? (v[e >> 1] >> 16) : (v[e >> 1] & 0xFFFFu)); }

__device__ void gla_phase(const Params& p, LAS unsigned char* lds) {
    constexpr int SQ = 136, SJ = 72, SO = 132;
    LAS bf16_t* Qt = (LAS bf16_t*)lds;
    LAS bf16_t* Qh = Qt + 64 * SQ;
    LAS bf16_t* Kt = Qh + 64 * SQ;
    LAS bf16_t* Kh = Kt + 64 * SQ;
    LAS bf16_t* Vm = Kh + 64 * SQ;
    LAS bf16_t* Am = Vm + 64 * SQ;
    LAS float* Os = (LAS float*)(Am + 64 * SJ);
    LAS float* tot = Os + 64 * SO;
    LAS float* dk = tot + 512;
    LAS bf16_t* Rq = Am;
    LAS bf16_t* Rf = Rq + 64 * SQ;
    const int t = otid(), w = t >> 6, lane = t & 63, q = lane >> 4, c = lane & 15;
    const int ch = t & 127, rg = t >> 7;
    const int lr0 = t >> 4, lcg = t & 15, orow = t >> 3, ovs = (t & 7) * 16;
    const bf16_t* P = (const bf16_t*)(p.ws + WS_P);
    bf16_t* Ob = (bf16_t*)(p.ws + WS_P + P_OBUF);
    const u32x4 zero4 = {0u, 0u, 0u, 0u};
    for (int unit = blockIdx.x; unit < 192; unit += gridDim.x) {
        const int s = unit < 128 ? (unit >> 3) : 16 + ((unit - 128) >> 3), h = unit & 7;
        const int T = s < 16 ? 4096 : 16, row0 = s < 16 ? s * 4096 : NP + (s - 16) * 16;
        const int nch = (T + 63) >> 6;
        f32x4 S[8];
        float* sout = s < 16 ? p.out + OFF_HGP + (size_t)(s * 8 + h) * 16384 : p.out + OFF_HGS + (size_t)((s - 16) * 8 + h) * 16384;
        LAS float* St = (LAS float*)lds;
        if (s >= 16) {
            const float* sp = p.in[I_SHG] + (size_t)((s - 16) * 8 + h) * 16384;
#pragma unroll
            for (int i = 0; i < 8; ++i) { const int idx = t + 512 * i, kk = idx >> 5, v4 = idx & 31; *(LAS f32x4*)(St + kk * 132 + 4 * v4) = *(const f32x4*)(sp + kk * 128 + 4 * v4); }
            __syncthreads();
#pragma unroll
            for (int kt = 0; kt < 8; ++kt)
#pragma unroll
                for (int r = 0; r < 4; ++r) S[kt][r] = St[(16 * kt + 4 * q + r) * 132 + 16 * w + c];
        } else {
#pragma unroll
            for (int kt = 0; kt < 8; ++kt) S[kt] = (f32x4){0.f, 0.f, 0.f, 0.f};
        }
        u32x4 nq0, nq1, nf0, nf1, nv0, nv1, ng0, ng1;
#define GLA_LOAD(CHK) do { const int _l0 = (CHK) * 64; const size_t _rb = (size_t)row0 + _l0; \
            const bf16_t* _p0 = P + (_rb + lr0) * 4096 + h * 128 + 8 * lcg; const bf16_t* _p1 = _p0 + (size_t)32 * 4096; \
            const bool _ok0 = _l0 + lr0 < T, _ok1 = _l0 + lr0 + 32 < T; \
            nq0 = _ok0 ? *(const u32x4*)_p0 : zero4; nf0 = _ok0 ? *(const u32x4*)(_p0 + 1024) : zero4; nv0 = _ok0 ? *(const u32x4*)(_p0 + 2048) : zero4; \
            nq1 = _ok1 ? *(const u32x4*)_p1 : zero4; nf1 = _ok1 ? *(const u32x4*)(_p1 + 1024) : zero4; nv1 = _ok1 ? *(const u32x4*)(_p1 + 2048) : zero4; \
            const bf16_t* _pg = P + (_rb + orow) * 4096 + 3072 + h * 128 + ovs; const bool _okg = _l0 + orow < T; \
            ng0 = _okg ? *(const u32x4*)_pg : zero4; ng1 = _okg ? *(const u32x4*)(_pg + 8) : zero4; } while (0)
        GLA_LOAD(0);
        for (int chk = 0; chk < nch; ++chk) {
            const int rbase = row0 + chk * 64;
            const u32x4 cg0 = ng0, cg1 = ng1;
            *(LAS u32x4*)(Rq + lr0 * SQ + 8 * lcg) = nq0; *(LAS u32x4*)(Rq + (lr0 + 32) * SQ + 8 * lcg) = nq1;
            *(LAS u32x4*)(Rf + lr0 * SQ + 8 * lcg) = nf0; *(LAS u32x4*)(Rf + (lr0 + 32) * SQ + 8 * lcg) = nf1;
            *(LAS u32x4*)(Vm + lr0 * SQ + 8 * lcg) = nv0; *(LAS u32x4*)(Vm + (lr0 + 32) * SQ + 8 * lcg) = nv1;
            __syncthreads();
            float qf[16], kf[16], G[16];
            float run = 0.f;
#pragma unroll
            for (int e = 0; e < 16; ++e) {
                qf[e] = bf2f(Rq[(rg * 16 + e) * SQ + ch]);
                const float lf = __half2float(__ushort_as_half(Rf[(rg * 16 + e) * SQ + ch]));
                kf[e] = 1.f - __expf(lf);
                run += lf; G[e] = run;
            }
            tot[rg * 128 + ch] = run;
            __syncthreads();
            const float t0 = tot[ch], t1 = tot[128 + ch], t2 = tot[256 + ch], t3 = tot[384 + ch];
            const float off = rg == 0 ? 0.f : rg == 1 ? t0 : rg == 2 ? t0 + t1 : t0 + t1 + t2;
            const float Gm = t0 + t1, Gl = Gm + t2 + t3;
            if (rg == 0) dk[ch] = __expf(Gl);
            const float eGm = __expf(Gm), eGlm = __expf(Gl - Gm);
#pragma unroll
            for (int e = 0; e < 16; ++e) {
                const float g = off + G[e]; const int i = rg * 16 + e;
                const float e1 = __expf(g - Gm), e3 = __expf(Gm - g);
                Qt[i * SQ + ch] = f2bf(qf[e] * e1); Qh[i * SQ + ch] = f2bf(qf[e] * (e1 * eGm)); Kt[i * SQ + ch] = f2bf(kf[e] * e3);
                Kh[i * SQ + ch] = f2bf(kf[e] * (e3 * eGlm));
            }
            __syncthreads();
            if (chk + 1 < nch) GLA_LOAD(chk + 1);
            {
                const int jt = w >> 1;
#pragma unroll
                for (int u = 0; u < 2; ++u) {
                    const int it = 2 * (w & 1) + u; f32x4 a = {0.f, 0.f, 0.f, 0.f};
#pragma unroll
                    for (int ks = 0; ks < 4; ++ks) {
                        const bf16x8 af = *(const LAS bf16x8*)(Kt + (16 * jt + c) * SQ + 32 * ks + 8 * q);
                        const bf16x8 bf = *(const LAS bf16x8*)(Qt + (16 * it + c) * SQ + 32 * ks + 8 * q);
                        a = mfma16(af, bf, a);
                    }
                    const int i = 16 * it + c, j0 = 16 * jt + 4 * q;
                    u32x2 o; o.x = pk2(j0 <= i ? a[0] : 0.f, j0 + 1 <= i ? a[1] : 0.f); o.y = pk2(j0 + 2 <= i ? a[2] : 0.f, j0 + 3 <= i ? a[3] : 0.f);
                    *(LAS u32x2*)(Am + i * SJ + j0) = o;
                }
            }
            __syncthreads();
            {
                f32x4 O[4];
#pragma unroll
                for (int it = 0; it < 4; ++it) O[it] = (f32x4){0.f, 0.f, 0.f, 0.f};
                bf16x8 vf[2];
#pragma unroll
                for (int ks = 0; ks < 2; ++ks) vf[ks] = tr_frag(Vm, SQ, 32 * ks, 16 * w, lane);
                LDS_DRAIN2(vf[0], vf[1]);
#pragma unroll
                for (int it = 0; it < 4; ++it)
#pragma unroll
                    for (int ks = 0; ks < 2; ++ks) O[it] = mfma16(*(const LAS bf16x8*)(Am + (16 * it + c) * SJ + 32 * ks + 8 * q), vf[ks], O[it]);
#pragma unroll
                for (int ks = 0; ks < 4; ++ks) {
                    u32x4 sb; sb.x = pk2(S[2 * ks][0], S[2 * ks][1]); sb.y = pk2(S[2 * ks][2], S[2 * ks][3]); sb.z = pk2(S[2 * ks + 1][0], S[2 * ks + 1][1]); sb.w = pk2(S[2 * ks + 1][2], S[2 * ks + 1][3]);
#pragma unroll
                    for (int it = 0; it < 4; ++it) {
                        const u32x2 lo = *(const LAS u32x2*)(Qh + (16 * it + c) * SQ + 32 * ks + 4 * q), hi = *(const LAS u32x2*)(Qh + (16 * it + c) * SQ + 32 * ks + 16 + 4 * q);
                        u32x4 af; af.x = lo.x; af.y = lo.y; af.z = hi.x; af.w = hi.y;
                        O[it] = mfma16(as_bf8(af), as_bf8(sb), O[it]);
                    }
                }
#pragma unroll
                for (int it = 0; it < 4; ++it)
#pragma unroll
                    for (int r = 0; r < 4; ++r) Os[(16 * it + 4 * q + r) * SO + 16 * w + c] = O[it][r];
#pragma unroll
                for (int kt = 0; kt < 8; ++kt) {
                    const f32x4 d = *(const LAS f32x4*)(dk + 16 * kt + 4 * q);
                    S[kt] = S[kt] * d;
                    { bf16x8 af0 = tr_frag(Kh, SQ, 0, 16 * kt, lane), af1 = tr_frag(Kh, SQ, 32, 16 * kt, lane); LDS_DRAIN2(af0, af1);
                      S[kt] = mfma16(af0, vf[0], S[kt]); S[kt] = mfma16(af1, vf[1], S[kt]); }
                }
            }
            __syncthreads();
            {
                const int li = chk * 64 + orow;
                float x[16]; float ss = 0.f;
#pragma unroll
                for (int j = 0; j < 4; ++j) { const f32x4 v4 = *(const LAS f32x4*)(Os + orow * SO + ovs + 4 * j); x[4 * j] = v4[0]; x[4 * j + 1] = v4[1]; x[4 * j + 2] = v4[2]; x[4 * j + 3] = v4[3];
                    ss += v4[0] * v4[0] + v4[1] * v4[1] + v4[2] * v4[2] + v4[3] * v4[3]; }
                ss += __shfl_xor(ss, 1); ss += __shfl_xor(ss, 2); ss += __shfl_xor(ss, 4);
                const float rs = rsqrtf(ss * (1.f / 128.f) + 1e-6f);
                if (li < T) {
                    const size_t r = (size_t)rbase + orow;
                    const float* nw = p.in[I_HGNW] + h * 128 + ovs;
                    float o[16];
#pragma unroll
                    for (int e = 0; e < 16; ++e) {
                        const float gs = bf2f(e < 8 ? elem16(cg0, e) : elem16(cg1, e - 8));
                        o[e] = x[e] * rs * nw[e] * gs;
                    }
                    u32x4 w0, w1;
                    w0.x = pk2(o[0], o[1]); w0.y = pk2(o[2], o[3]); w0.z = pk2(o[4], o[5]); w0.w = pk2(o[6], o[7]);
                    w1.x = pk2(o[8], o[9]); w1.y = pk2(o[10], o[11]); w1.z = pk2(o[12], o[13]); w1.w = pk2(o[14], o[15]);
                    bf16_t* op = Ob + r * 1024 + h * 128 + ovs;
                    *(u32x4*)op = w0; *(u32x4*)(op + 8) = w1;
                }
            }
            __syncthreads();
        }
#undef GLA_LOAD
#pragma unroll
        for (int kt = 0; kt < 8; ++kt)
#pragma unroll
            for (int r = 0; r < 4; ++r) St[(16 * kt + 4 * q + r) * 132 + 16 * w + c] = S[kt][r];
        __syncthreads();
#pragma unroll
        for (int i = 0; i < 8; ++i) { const int idx = t + 512 * i, kk = idx >> 5, v4 = idx & 31; *(f32x4*)(sout + kk * 128 + 4 * v4) = *(const LAS f32x4*)(St + kk * 132 + 4 * v4); }
        __syncthreads();
    }
}

__device__ void conv_phase(const Params& p, const XcdBarrier& xb) {
    const int gt = blockIdx.x * 512 + otid();
    bf16_t* P = (bf16_t*)(p.ws + WS_P);
    const bool active = gt < 101376;
    int s = 0, row_start = 0, nrows = 0, cgp = 0; bool first = true, last_seg = false;
    if (gt < 98304) { cgp = gt % 384; const int sg = gt / 384; s = sg >> 4; const int seg = sg & 15; row_start = s * 4096 + seg * 256; nrows = 256; first = seg == 0; last_seg = seg == 15; }
    else if (active) { const int k = gt - 98304; cgp = k % 384; s = 16 + k / 384; row_start = NP + (s - 16) * 16; nrows = 16; first = true; last_seg = true; }
    const int ch0 = cgp * 8;
    float hx[3][8];
#pragma unroll
    for (int j = 0; j < 3; ++j)
#pragma unroll
        for (int c = 0; c < 8; ++c) hx[j][c] = 0.f;
    if (active) {
        if (!first) {
#pragma unroll
            for (int j = 0; j < 3; ++j) {
                const u32x4 v = *(const u32x4*)(P + (size_t)(row_start - 3 + j) * 5120 + 2048 + ch0);
#pragma unroll
                for (int c = 0; c < 4; ++c) { hx[j][2 * c] = bflo(v[c]); hx[j][2 * c + 1] = bfhi(v[c]); }
            }
        } else if (s >= 16) {
#pragma unroll
            for (int j = 0; j < 3; ++j) {
                const float* sp = p.in[I_SCONV] + (size_t)((s - 16) * 3 + j) * 3072 + ch0;
                const f32x4 a = *(const f32x4*)sp, b = *(const f32x4*)(sp + 4);
#pragma unroll
                for (int c = 0; c < 4; ++c) { hx[j][c] = a[c]; hx[j][4 + c] = b[c]; }
            }
        }
    }
    xcd_barrier(xb);
    if (active) {
        float w0[8], w1[8], w2[8], w3[8], cb[8];
#pragma unroll
        for (int c = 0; c < 8; ++c) { w0[c] = p.in[I_CONVW][ch0 + c]; w1[c] = p.in[I_CONVW][3072 + ch0 + c]; w2[c] = p.in[I_CONVW][6144 + ch0 + c]; w3[c] = p.in[I_CONVW][9216 + ch0 + c]; cb[c] = p.in[I_CONVB][ch0 + c]; }
        bf16_t* colp = P + (size_t)row_start * 5120 + 2048 + ch0;
#pragma unroll 1
        for (int r0 = 0; r0 < nrows; r0 += 8) {
            u32x4 raw[8];
#pragma unroll
            for (int i = 0; i < 8; ++i) raw[i] = *(const u32x4*)(colp + (size_t)(r0 + i) * 5120);
#pragma unroll
            for (int i = 0; i < 8; ++i) {
                float x[8], o[8];
#pragma unroll
                for (int c = 0; c < 4; ++c) { x[2 * c] = bflo(raw[i][c]); x[2 * c + 1] = bfhi(raw[i][c]); }
#pragma unroll
                for (int c = 0; c < 8; ++c) {
                    o[c] = siluf_(cb[c] + w0[c] * hx[0][c] + w1[c] * hx[1][c] + w2[c] * hx[2][c] + w3[c] * x[c]);
                    hx[0][c] = hx[1][c]; hx[1][c] = hx[2][c]; hx[2][c] = x[c];
                }
                u32x4 ov; ov.x = pk2(o[0], o[1]); ov.y = pk2(o[2], o[3]); ov.z = pk2(o[4], o[5]); ov.w = pk2(o[6], o[7]);
                *(u32x4*)(colp + (size_t)(r0 + i) * 5120) = ov;
            }
        }
        if (last_seg) {
            float* cp = s < 16 ? p.out + OFF_CVP + (size_t)s * 9216 : p.out + OFF_CVS + (size_t)(s - 16) * 9216;
#pragma unroll
            for (int j = 0; j < 3; ++j) {
                f32x4 a, b;
#pragma unroll
                for (int c = 0; c < 4; ++c) { a[c] = hx[j][c]; b[c] = hx[j][4 + c]; }
                *(f32x4*)(cp + j * 3072 + ch0) = a; *(f32x4*)(cp + j * 3072 + ch0 + 4) = b;
            }
        }
    }
}

__device__ void ssd_phase(const Params& p, LAS unsigned char* lds) {
    constexpr int SN = 136, SJ = 72, SY = 68;
    constexpr int HB_BYTES = (64 * SN + 3 * 64 * SJ) * 2 + 64 * SY * 4;
    LAS bf16_t* Bm = (LAS bf16_t*)lds;
    LAS bf16_t* Cm = Bm + 64 * SN;
    LAS unsigned char* hb0 = lds + 2 * 64 * SN * 2;
    LAS float* dsc = (LAS float*)(hb0 + 2 * HB_BYTES);
#define SSD_HT(hh) ((LAS bf16_t*)(hb0 + (hh) * HB_BYTES))
#define SSD_XS(hh) (SSD_HT(hh) + 64 * SN)
#define SSD_XH(hh) (SSD_XS(hh) + 64 * SJ)
#define SSD_WM(hh) (SSD_XH(hh) + 64 * SJ)
#define SSD_YS(hh) ((LAS float*)(SSD_WM(hh) + 64 * SJ))
#define SSD_DTV(hh) (dsc + (hh) * 256)
#define SSD_ACU(hh) (dsc + (hh) * 256 + 64)
#define SSD_WDV(hh) (dsc + (hh) * 256 + 128)
#define SSD_EAV(hh) (dsc + (hh) * 256 + 192)
    const int t = otid(), w = t >> 6, lane = t & 63, q = lane >> 4, c = lane & 15;
    const int lrow = t >> 4, lcg = t & 15, lhh = lcg >> 3, lcl = lcg & 7;
    const int mhh = w >> 2, mw = w & 3;
    bf16_t* P = (bf16_t*)(p.ws + WS_P);
    const float* DT = (const float*)(p.ws + WS_DT);
    const u32x4 zero4 = {0u, 0u, 0u, 0u};
    for (int unit = blockIdx.x; unit < 384; unit += gridDim.x) {
        const int uu = unit < 256 ? unit : unit - 256;
        const int s = (unit < 256 ? 0 : 16) + (uu >> 4), grp = (uu >> 2) & 3, h0 = grp * 8 + 2 * (uu & 3);
        const int T = s < 16 ? 4096 : 16, row0 = s < 16 ? s * 4096 : NP + (s - 16) * 16;
        const int nch = (T + 63) >> 6;
        const float a_neg = -__expf(p.in[I_ALOG][h0 + (w & 1)]);
        const float Dl = p.in[I_SSMD][h0 + lhh];
        f32x4 Hs[2][4];
        {
            const int hh_ = h0 + mhh;
            float* sout = s < 16 ? p.out + OFF_SSMP + (size_t)(s * 32 + hh_) * 8192 : p.out + OFF_SSMS + (size_t)((s - 16) * 32 + hh_) * 8192;
            (void)sout;
#pragma unroll
            for (int nn = 0; nn < 2; ++nn)
#pragma unroll
                for (int pt = 0; pt < 4; ++pt) {
                    const int nt = 2 * mw + nn;
                    if (s >= 16) Hs[nn][pt] = *(const f32x4*)(p.in[I_SSSM] + (size_t)((s - 16) * 32 + hh_) * 8192 + (16 * pt + c) * 128 + 16 * nt + 4 * q);
                    else Hs[nn][pt] = (f32x4){0.f, 0.f, 0.f, 0.f};
                    u32x2 o; o.x = pk2(Hs[nn][pt][0], Hs[nn][pt][1]); o.y = pk2(Hs[nn][pt][2], Hs[nn][pt][3]);
                    *(LAS u32x2*)(SSD_HT(mhh) + (16 * pt + c) * SN + 16 * nt + 4 * q) = o;
                }
        }
        u32x4 nx0, nx1, nz0, nz1, nb0, nb1, nc0, nc1; float ndt;
#define SSD_LOAD(CHK) do { const int _rb = row0 + (CHK) * 64; const int _l0 = (CHK) * 64; \
            const bf16_t* _r0 = P + (size_t)(_rb + lrow) * 5120; const bf16_t* _r1 = _r0 + (size_t)32 * 5120; \
            const bool _ok0 = _l0 + lrow < T, _ok1 = _l0 + lrow + 32 < T; \
            const int _xo = h0 * 64 + 8 * lcg, _bo = 4096 + grp * 128 + 8 * lcg; \
            nz0 = _ok0 ? *(const u32x4*)(_r0 + _xo) : zero4; nx0 = _ok0 ? *(const u32x4*)(_r0 + 2048 + _xo) : zero4; \
            nb0 = _ok0 ? *(const u32x4*)(_r0 + _bo) : zero4; nc0 = _ok0 ? *(const u32x4*)(_r0 + _bo + 512) : zero4; \
            nz1 = _ok1 ? *(const u32x4*)(_r1 + _xo) : zero4; nx1 = _ok1 ? *(const u32x4*)(_r1 + 2048 + _xo) : zero4; \
            nb1 = _ok1 ? *(const u32x4*)(_r1 + _bo) : zero4; nc1 = _ok1 ? *(const u32x4*)(_r1 + _bo + 512) : zero4; \
            ndt = (w < 2 && _l0 + lane < T) ? DT[(size_t)(_rb + lane) * 32 + h0 + w] : 0.f; } while (0)
        SSD_LOAD(0);
        for (int chk = 0; chk < nch; ++chk) {
            const int rbase = row0 + chk * 64;
            const u32x4 cx0 = nx0, cx1 = nx1, cz0 = nz0, cz1 = nz1, cb0 = nb0, cb1 = nb1, cc0 = nc0, cc1 = nc1; const float cdt = ndt;
            if (w < 2) {
                float ar = cdt * a_neg;
#pragma unroll
                for (int d = 1; d < 64; d <<= 1) { const float v = __shfl_up(ar, d); if (lane >= d) ar += v; }
                const float al = __shfl(ar, 63);
                SSD_DTV(w)[lane] = cdt; SSD_ACU(w)[lane] = ar; SSD_WDV(w)[lane] = __expf(al - ar) * cdt; SSD_EAV(w)[lane] = __expf(ar);
            }
            __syncthreads();
            {
                const float wd0 = SSD_WDV(lhh)[lrow], wd1 = SSD_WDV(lhh)[lrow + 32];
                u32x4 xh0, xh1;
#pragma unroll
                for (int j = 0; j < 4; ++j) { xh0[j] = pk2(bflo(cx0[j]) * wd0, bfhi(cx0[j]) * wd0); xh1[j] = pk2(bflo(cx1[j]) * wd1, bfhi(cx1[j]) * wd1); }
                *(LAS u32x4*)(SSD_XS(lhh) + lrow * SJ + 8 * lcl) = cx0; *(LAS u32x4*)(SSD_XS(lhh) + (lrow + 32) * SJ + 8 * lcl) = cx1;
                *(LAS u32x4*)(SSD_XH(lhh) + lrow * SJ + 8 * lcl) = xh0; *(LAS u32x4*)(SSD_XH(lhh) + (lrow + 32) * SJ + 8 * lcl) = xh1;
                *(LAS u32x4*)(Bm + lrow * SN + 8 * lcg) = cb0; *(LAS u32x4*)(Bm + (lrow + 32) * SN + 8 * lcg) = cb1;
                *(LAS u32x4*)(Cm + lrow * SN + 8 * lcg) = cc0; *(LAS u32x4*)(Cm + (lrow + 32) * SN + 8 * lcg) = cc1;
            }
            if (chk + 1 < nch) SSD_LOAD(chk + 1);
            __syncthreads();
            {
                const int jt = w >> 1;
#pragma unroll
                for (int u = 0; u < 2; ++u) {
                    const int it = 2 * (w & 1) + u; f32x4 a = {0.f, 0.f, 0.f, 0.f};
#pragma unroll
                    for (int ks = 0; ks < 4; ++ks) {
                        const bf16x8 af = *(const LAS bf16x8*)(Bm + (16 * jt + c) * SN + 32 * ks + 8 * q);
                        const bf16x8 bf = *(const LAS bf16x8*)(Cm + (16 * it + c) * SN + 32 * ks + 8 * q);
                        a = mfma16(af, bf, a);
                    }
                    const int i = 16 * it + c, j0 = 16 * jt + 4 * q;
#pragma unroll
                    for (int hh = 0; hh < 2; ++hh) {
                        const float ai = SSD_ACU(hh)[i];
                        float wv[4];
#pragma unroll
                        for (int r = 0; r < 4; ++r) { const int j = j0 + r; wv[r] = j <= i ? a[r] * __expf(ai - SSD_ACU(hh)[j]) * SSD_DTV(hh)[j] : 0.f; }
                        u32x2 o; o.x = pk2(wv[0], wv[1]); o.y = pk2(wv[2], wv[3]);
                        *(LAS u32x2*)(SSD_WM(hh) + i * SJ + j0) = o;
                    }
                }
            }
            __syncthreads();
            {
                const int it = mw;
                bf16x8 wf[2], cf[4];
#pragma unroll
                for (int ks = 0; ks < 2; ++ks) wf[ks] = *(const LAS bf16x8*)(SSD_WM(mhh) + (16 * it + c) * SJ + 32 * ks + 8 * q);
#pragma unroll
                for (int ks = 0; ks < 4; ++ks) cf[ks] = *(const LAS bf16x8*)(Cm + (16 * it + c) * SN + 32 * ks + 8 * q);
                const f32x4 ea = *(const LAS f32x4*)(SSD_EAV(mhh) + 16 * it + 4 * q);
#pragma unroll
                for (int pt = 0; pt < 4; ++pt) {
                    f32x4 Y1 = {0.f, 0.f, 0.f, 0.f}, Y2 = {0.f, 0.f, 0.f, 0.f};
                    { bf16x8 xf0 = tr_frag(SSD_XS(mhh), SJ, 0, 16 * pt, lane), xf1 = tr_frag(SSD_XS(mhh), SJ, 32, 16 * pt, lane); LDS_DRAIN2(xf0, xf1);
                      Y1 = mfma16(wf[0], xf0, Y1); Y1 = mfma16(wf[1], xf1, Y1); }
#pragma unroll
                    for (int ks = 0; ks < 4; ++ks) Y2 = mfma16(cf[ks], *(const LAS bf16x8*)(SSD_HT(mhh) + (16 * pt + c) * SN + 32 * ks + 8 * q), Y2);
#pragma unroll
                    for (int r = 0; r < 4; ++r) SSD_YS(mhh)[(16 * it + 4 * q + r) * SY + 16 * pt + c] = Y1[r] + ea[r] * Y2[r];
                }
            }
            {
                const float el = SSD_EAV(mhh)[63];
#pragma unroll
                for (int nn = 0; nn < 2; ++nn) {
                    const int nt = 2 * mw + nn;
                    bf16x8 bt[2];
#pragma unroll
                    for (int ks = 0; ks < 2; ++ks) bt[ks] = tr_frag(Bm, SN, 32 * ks, 16 * nt, lane);
                    LDS_DRAIN2(bt[0], bt[1]);
#pragma unroll
                    for (int pt = 0; pt < 4; ++pt) {
                        Hs[nn][pt] = Hs[nn][pt] * el;
                        { bf16x8 xf0 = tr_frag(SSD_XH(mhh), SJ, 0, 16 * pt, lane), xf1 = tr_frag(SSD_XH(mhh), SJ, 32, 16 * pt, lane); LDS_DRAIN2(xf0, xf1);
                          Hs[nn][pt] = mfma16(bt[0], xf0, Hs[nn][pt]); Hs[nn][pt] = mfma16(bt[1], xf1, Hs[nn][pt]); }
                    }
                }
            }
            __syncthreads();
#pragma unroll
            for (int nn = 0; nn < 2; ++nn)
#pragma unroll
                for (int pt = 0; pt < 4; ++pt) {
                    u32x2 o; o.x = pk2(Hs[nn][pt][0], Hs[nn][pt][1]); o.y = pk2(Hs[nn][pt][2], Hs[nn][pt][3]);
                    *(LAS u32x2*)(SSD_HT(mhh) + (16 * pt + c) * SN + 16 * (2 * mw + nn) + 4 * q) = o;
                }
#pragma unroll
            for (int hr = 0; hr < 2; ++hr) {
                const int rr = lrow + 32 * hr;
                if (chk * 64 + rr < T) {
                    const u32x4 xv = hr ? cx1 : cx0, zv = hr ? cz1 : cz0;
                    const f32x4 y0 = *(const LAS f32x4*)(SSD_YS(lhh) + rr * SY + 8 * lcl), y1 = *(const LAS f32x4*)(SSD_YS(lhh) + rr * SY + 8 * lcl + 4);
                    float o[8];
#pragma unroll
                    for (int e = 0; e < 8; ++e) {
                        const float y = (e < 4 ? y0[e & 3] : y1[e & 3]) + Dl * bf2f(elem16(xv, e));
                        o[e] = y * siluf_(bf2f(elem16(zv, e)));
                    }
                    u32x4 ov; ov.x = pk2(o[0], o[1]); ov.y = pk2(o[2], o[3]); ov.z = pk2(o[4], o[5]); ov.w = pk2(o[6], o[7]);
                    *(u32x4*)(P + (size_t)(rbase + rr) * 5120 + h0 * 64 + 8 * lcg) = ov;
                }
            }
        }
#undef SSD_LOAD
        {
            const int hh_ = h0 + mhh;
            float* sout = s < 16 ? p.out + OFF_SSMP + (size_t)(s * 32 + hh_) * 8192 : p.out + OFF_SSMS + (size_t)((s - 16) * 32 + hh_) * 8192;
#pragma unroll
            for (int nn = 0; nn < 2; ++nn)
#pragma unroll
                for (int pt = 0; pt < 4; ++pt) *(f32x4*)(sout + (16 * pt + c) * 128 + 16 * (2 * mw + nn) + 4 * q) = Hs[nn][pt];
        }
        __syncthreads();
    }
#undef SSD_HT
#undef SSD_XS
#undef SSD_XH
#undef SSD_WM
#undef SSD_YS
#undef SSD_DTV
#undef SSD_ACU
#undef SSD_WDV
#undef SSD_EAV
}

__device__ void ynorm_phase(const Params& p) {
    const int t_ = otid(), w = t_ >> 6, lane = t_ & 63;
    bf16_t* P = (bf16_t*)(p.ws + WS_P);
    bf16_t* YN = (bf16_t*)p.out;
    const int nwaves = gridDim.x * 8;
    for (int r0 = blockIdx.x * 8 + w; r0 < NR; r0 += nwaves * 2) {
        u32x4 v[2][4];
#pragma unroll
        for (int k = 0; k < 2; ++k) {
            const int r = r0 + k * nwaves; const int rr = r < NR ? r : r0;
#pragma unroll
            for (int g = 0; g < 4; ++g) v[k][g] = *(const u32x4*)(P + (size_t)rr * 5120 + g * 512 + lane * 8);
        }
        float ss[2][4];
#pragma unroll
        for (int k = 0; k < 2; ++k)
#pragma unroll
            for (int g = 0; g < 4; ++g) {
                float s_ = 0.f;
#pragma unroll
                for (int j = 0; j < 4; ++j) { const float a = bflo(v[k][g][j]), b = bfhi(v[k][g][j]); s_ += a * a + b * b; }
                ss[k][g] = s_;
            }
#pragma unroll
        for (int d = 32; d >= 1; d >>= 1) {
#pragma unroll
            for (int k = 0; k < 2; ++k)
#pragma unroll
                for (int g = 0; g < 4; ++g) ss[k][g] += __shfl_xor(ss[k][g], d);
        }
#pragma unroll
        for (int k = 0; k < 2; ++k) {
            const int r = r0 + k * nwaves;
            if (r < NR) {
#pragma unroll
                for (int g = 0; g < 4; ++g) {
                    const float rs = rsqrtf(ss[k][g] * (1.f / 512.f) + 1e-6f);
                    const float* nw = p.in[I_SSMNW] + g * 512 + lane * 8;
                    const f32x4 n0 = *(const f32x4*)nw, n1 = *(const f32x4*)(nw + 4);
                    u32x4 o;
                    o.x = pk2(bflo(v[k][g][0]) * rs * n0[0], bfhi(v[k][g][0]) * rs * n0[1]); o.y = pk2(bflo(v[k][g][1]) * rs * n0[2], bfhi(v[k][g][1]) * rs * n0[3]);
                    o.z = pk2(bflo(v[k][g][2]) * rs * n1[0], bfhi(v[k][g][2]) * rs * n1[1]); o.w = pk2(bflo(v[k][g][3]) * rs * n1[2], bfhi(v[k][g][3]) * rs * n1[3]);
                    *(u32x4*)(YN + (size_t)r * 2048 + g * 512 + lane * 8) = o;
                }
            }
        }
    }
}

__device__ __forceinline__ int f2key(float f) { const int b = __float_as_int(f); return b ^ ((b >> 31) & 0x7FFFFFFF); }
__device__ __forceinline__ float key2f(int k) { return __int_as_float(k ^ ((k >> 31) & 0x7FFFFFFF)); }
#define TOPK_INSERT(arr, x) do { int _x = (x); _Pragma("unroll") for (int _i = 0; _i < 16; ++_i) { const int _hi = max(arr[_i], _x); _x = min(arr[_i], _x); arr[_i] = _hi; } } while (0)

__constant__ unsigned char c_cand[52] = {
    0x00, 0x01, 0x02, 0x03, 0x04, 0x05, 0x06, 0x07, 0x08, 0x09, 0x0A, 0x0B, 0x0C, 0x0D, 0x0E, 0x0F,
    0x10, 0x11, 0x12, 0x13, 0x14, 0x15, 0x16, 0x17, 0x20, 0x21, 0x22, 0x23, 0x24, 0x30, 0x31, 0x32, 0x33,
    0x40, 0x41, 0x42, 0x50, 0x51, 0x60, 0x61, 0x70, 0x71, 0x80, 0x90, 0xA0, 0xB0, 0xC0, 0xD0, 0xE0, 0xF0, 0x00, 0x00};

__device__ __forceinline__ void merge16(int (&t)[16], int xr) {
    int b[16];
#pragma unroll
    for (int i = 0; i < 16; ++i) b[i] = __shfl_xor(t[15 - i], xr);
#pragma unroll
    for (int i = 0; i < 16; ++i) t[i] = max(t[i], b[i]);
#pragma unroll
    for (int s = 8; s >= 1; s >>= 1)
#pragma unroll
        for (int i = 0; i < 16; ++i)
            if ((i & s) == 0) { const int hi = max(t[i], t[i + s]), lo = min(t[i], t[i + s]); t[i] = hi; t[i + s] = lo; }
}

__device__ void route_phase(const Params& p, LAS unsigned char* lds) {
    const int t = otid(), w = t >> 6, lane = t & 63, q = lane >> 4, c = lane & 15;
    LAS float* sc = (LAS float*)(lds + w * 16640);
    LAS int* il = (LAS int*)sc;
    LAS float* vl = sc + 544;
    const bf16_t* Qb = (const bf16_t*)(p.ws + WS_P + P_QB);
    const bf16_t* K1 = (const bf16_t*)(p.ws + WS_K1); const bf16_t* K2 = (const bf16_t*)(p.ws + WS_K2);
    int* EIDX = (int*)(p.ws + WS_P + P_EIDX); float* GW = (float*)(p.ws + WS_P + P_GW);
    const int nunits = (NR / 16) * 8;
    const int tok = lane >> 2, hf = (lane >> 1) & 1, sub = lane & 1, cj = lane & 3;
    for (int u = blockIdx.x * 8 + w; u < nunits; u += gridDim.x * 8) {
        const int tg = u >> 3, h = u & 7, r0 = tg * 16;
        int top[16];
#pragma unroll
        for (int i = 0; i < 16; ++i) top[i] = (int)0x80000000;
        {
            const bf16_t* sp = Qb + (size_t)(r0 + tok) * 2048 + h * 256 + hf * 128 + sub * 64;
            u32x4 sv[8];
#pragma unroll
            for (int j8 = 0; j8 < 8; ++j8) sv[j8] = *(const u32x4*)(sp + 8 * j8);
#pragma unroll
            for (int j8 = 0; j8 < 8; ++j8)
#pragma unroll
                for (int e = 0; e < 8; ++e) {
                    const unsigned hw = (e & 1) ? (sv[j8][e >> 1] >> 16) : (sv[j8][e >> 1] & 0xFFFFu);
                    const float v = __half2float(__ushort_as_half((unsigned short)hw));
                    const int key = (f2key(v) & ~127) | (sub * 64 + 8 * j8 + e);
                    TOPK_INSERT(top, key);
                }
        }
        merge16(top, 1);
        asm volatile("s_waitcnt lgkmcnt(0)" ::: "memory");
        if (sub == 0) {
            const int lst = lane >> 1;
#pragma unroll
            for (int i = 0; i < 16; ++i) { il[lst * 17 + i] = top[i] & 127; vl[lst * 17 + i] = key2f(top[i] & ~127); }
        }
        asm volatile("s_waitcnt lgkmcnt(0)" ::: "memory");
        int ft[16];
#pragma unroll
        for (int i = 0; i < 16; ++i) ft[i] = (int)0x80000000;
#pragma unroll
        for (int m = 0; m < 13; ++m) {
            const int n = 4 * m + cj; const bool okc = n < 50;
            const int code = c_cand[okc ? n : 0];
            const float v = vl[(tok * 2) * 17 + (code >> 4)] + vl[(tok * 2 + 1) * 17 + (code & 15)];
            const int key = okc ? ((f2key(v) & ~255) | code) : (int)0x80000000;
            TOPK_INSERT(ft, key);
        }
        merge16(ft, 1); merge16(ft, 2);
        {
            float ev[16]; float sum = 0.f; const float mx = key2f(ft[0] & ~255);
#pragma unroll
            for (int i = 0; i < 16; ++i) { ev[i] = __expf(key2f(ft[i] & ~255) - mx); sum += ev[i]; }
            const float inv = 1.f / sum;
            if (cj == 0) {
                int ei[16];
#pragma unroll
                for (int i = 0; i < 16; ++i) { const int code = ft[i] & 255; ei[i] = il[(tok * 2) * 17 + (code >> 4)] * 128 + il[(tok * 2 + 1) * 17 + (code & 15)]; ev[i] *= inv; }
                int* ep = EIDX + ((size_t)(r0 + tok) * 8 + h) * 16; float* gp = GW + ((size_t)(r0 + tok) * 8 + h) * 16;
#pragma unroll
                for (int i = 0; i < 4; ++i) { *(int4*)(ep + 4 * i) = make_int4(ei[4 * i], ei[4 * i + 1], ei[4 * i + 2], ei[4 * i + 3]); *(float4*)(gp + 4 * i) = make_float4(ev[4 * i], ev[4 * i + 1], ev[4 * i + 2], ev[4 * i + 3]); }
            }
        }
        asm volatile("s_waitcnt lgkmcnt(0)" ::: "memory");
    }
}

typedef float f32x2 __attribute__((ext_vector_type(2)));
__device__ __forceinline__ void fp8x16_to_f32(const u32x4 q, float (&f)[16]) {
#pragma unroll
    for (int j = 0; j < 4; ++j) {
        const f32x2 lo = __builtin_amdgcn_cvt_pk_f32_fp8((int)q[j], false), hi = __builtin_amdgcn_cvt_pk_f32_fp8((int)q[j], true);
        f[4 * j] = lo.x; f[4 * j + 1] = lo.y; f[4 * j + 2] = hi.x; f[4 * j + 3] = hi.y;
    }
}

__device__ void expert_phase(const Params& p, LAS unsigned char* lds) {
    const int t_ = otid(), w = t_ >> 6, lane = t_ & 63;
    const bf16_t* H = (const bf16_t*)(p.ws + WS_H);
    const unsigned char* U8 = (const unsigned char*)(p.ws + WS_U); const unsigned char* V8 = (const unsigned char*)(p.ws + WS_V);
    const bf16_t* SC = (const bf16_t*)(p.ws + WS_P + P_QB);
    const float* X1 = (const float*)(p.ws + WS_P + P_X1);
    const float* mod = (const float*)(p.ws + WS_MOD);
    const int xi = (lane >> 3) & 7;
    for (int r = blockIdx.x * 8 + w; r < NR; r += gridDim.x * 8) {
        const bf16_t* hr = H + (size_t)r * 1024 + lane * 16;
        const u32x4 ha = *(const u32x4*)hr, hb = *(const u32x4*)(hr + 8);
        float hf[16];
#pragma unroll
        for (int j = 0; j < 4; ++j) { hf[2 * j] = bflo(ha[j]); hf[2 * j + 1] = bfhi(ha[j]); hf[8 + 2 * j] = bflo(hb[j]); hf[8 + 2 * j + 1] = bfhi(hb[j]); }
        int e0, e1; float g0, g1;
        {
            const int hd = lane >> 3, hf = (lane >> 2) & 1, qt = lane & 3, cj8 = lane & 7;
            LAS int* il = (LAS int*)(lds + w * 4096);
            LAS float* vl = (LAS float*)(il + 272);
            LAS int* se = il + 544;
            LAS float* sg = (LAS float*)(il + 672);
            int top[16];
#pragma unroll
            for (int i = 0; i < 16; ++i) top[i] = (int)0x80000000;
            {
                const bf16_t* sp = SC + (size_t)r * 2048 + hd * 256 + hf * 128 + qt * 32;
                u32x4 sv[4];
#pragma unroll
                for (int j8 = 0; j8 < 4; ++j8) sv[j8] = *(const u32x4*)(sp + 8 * j8);
#pragma unroll
                for (int j8 = 0; j8 < 4; ++j8)
#pragma unroll
                    for (int e = 0; e < 8; ++e) {
                        const unsigned hw = (e & 1) ? (sv[j8][e >> 1] >> 16) : (sv[j8][e >> 1] & 0xFFFFu);
                        const float v = __half2float(__ushort_as_half((unsigned short)hw));
                        const int key = (f2key(v) & ~127) | (qt * 32 + 8 * j8 + e);
                        TOPK_INSERT(top, key);
                    }
            }
            merge16(top, 1); merge16(top, 2);
            asm volatile("s_waitcnt lgkmcnt(0)" ::: "memory");
            if (qt == 0) {
                const int lst = hd * 2 + hf;
#pragma unroll
                for (int i = 0; i < 16; ++i) { il[lst * 17 + i] = top[i] & 127; vl[lst * 17 + i] = key2f(top[i] & ~127); }
            }
            asm volatile("s_waitcnt lgkmcnt(0)" ::: "memory");
            int ft[16];
#pragma unroll
            for (int i = 0; i < 16; ++i) ft[i] = (int)0x80000000;
#pragma unroll
            for (int m = 0; m < 7; ++m) {
                const int n = 8 * m + cj8; const bool okc = n < 50;
                const int code = c_cand[okc ? n : 0];
                const float v = vl[(hd * 2) * 17 + (code >> 4)] + vl[(hd * 2 + 1) * 17 + (code & 15)];
                const int key = okc ? ((f2key(v) & ~255) | code) : (int)0x80000000;
                TOPK_INSERT(ft, key);
            }
            merge16(ft, 1); merge16(ft, 2); merge16(ft, 4);
            float ev[16]; float sum = 0.f; const float mx = key2f(ft[0] & ~255);
#pragma unroll
            for (int i = 0; i < 16; ++i) { ev[i] = __expf(key2f(ft[i] & ~255) - mx); sum += ev[i]; }
            const float inv = 1.f / sum;
            if (cj8 == 0) {
#pragma unroll
                for (int i = 0; i < 16; ++i) { const int code = ft[i] & 255;
                    se[hd * 16 + i] = il[(hd * 2) * 17 + (code >> 4)] * 128 + il[(hd * 2 + 1) * 17 + (code & 15)]; sg[hd * 16 + i] = ev[i] * inv; }
            }
            asm volatile("s_waitcnt lgkmcnt(0)" ::: "memory");
            e0 = se[lane]; e1 = se[64 + lane]; g0 = sg[lane]; g1 = sg[64 + lane];
            asm volatile("s_waitcnt lgkmcnt(0)" ::: "memory");
        }
        float out[16];
#pragma unroll
        for (int i = 0; i < 16; ++i) out[i] = 0.f;
#pragma unroll 1
        for (int jb = 0; jb < 16; ++jb) {
            const int esel = jb < 8 ? e0 : e1; const float gsel = jb < 8 ? g0 : g1;
            const int jbase = (jb * 8) & 63;
            u32x4 uq[8], vq[8];
#pragma unroll
            for (int x = 0; x < 8; ++x) {
                const int e = __builtin_amdgcn_readlane(esel, jbase + x);
                uq[x] = *(const u32x4*)(U8 + (size_t)e * 1024 + lane * 16);
                vq[x] = *(const u32x4*)(V8 + (size_t)e * 1024 + lane * 16);
            }
            const float glane = __shfl(gsel, jbase + xi);
            float d[8];
#pragma unroll
            for (int x = 0; x < 8; ++x) {
                float uf[16]; fp8x16_to_f32(uq[x], uf);
                float a = 0.f;
#pragma unroll
                for (int k = 0; k < 16; ++k) a += hf[k] * uf[k];
                d[x] = a;
            }
            float d4[4], d2[2], d1;
            {
                const bool up = (lane & 32) != 0;
#pragma unroll
                for (int i = 0; i < 4; ++i) { const float send = up ? d[i] : d[4 + i], keep = up ? d[4 + i] : d[i]; d4[i] = keep + __shfl_xor(send, 32); }
            }
            {
                const bool up = (lane & 16) != 0;
#pragma unroll
                for (int i = 0; i < 2; ++i) { const float send = up ? d4[i] : d4[2 + i], keep = up ? d4[2 + i] : d4[i]; d2[i] = keep + __shfl_xor(send, 16); }
            }
            {
                const bool up = (lane & 8) != 0;
                const float send = up ? d2[0] : d2[1], keep = up ? d2[1] : d2[0]; d1 = keep + __shfl_xor(send, 8);
            }
            d1 += __shfl_xor(d1, 4); d1 += __shfl_xor(d1, 2); d1 += __shfl_xor(d1, 1);
            const float a = d1 * (1.f / 512.f);
            const float cwl = 0.5f * a * (1.f + erff(a * 0.70710678118f)) * glane;
#pragma unroll
            for (int x = 0; x < 8; ++x) {
                const float cw = __int_as_float(__builtin_amdgcn_readlane(__float_as_int(cwl), 8 * x));
                float vf[16]; fp8x16_to_f32(vq[x], vf);
#pragma unroll
                for (int k = 0; k < 16; ++k) out[k] += cw * vf[k];
            }
        }
        const float* g2 = mod + row_seq(r) * 6144 + 5120;
        const float* xr = X1 + (size_t)r * 1024;
        float x2[16]; float ss = 0.f;
#pragma unroll
        for (int j4 = 0; j4 < 4; ++j4) {
            const int cc = lane * 16 + j4 * 4;
            const f32x4 xv = *(const f32x4*)(xr + cc), gv = *(const f32x4*)(g2 + cc);
#pragma unroll
            for (int j = 0; j < 4; ++j) { const float v = xv[j] + gv[j] * out[j4 * 4 + j] * (1.f / 32.f); x2[j4 * 4 + j] = v; ss += v * v; }
        }
        ss = wave_sum(ss);
        const float rs = rsqrtf(ss * (1.f / 1024.f) + 1e-6f);
#pragma unroll
        for (int j4 = 0; j4 < 4; ++j4) {
            const int cc = lane * 16 + j4 * 4;
            const f32x4 fw = *(const f32x4*)(p.in[I_FNW] + cc);
            f32x4 o;
#pragma unroll
            for (int j = 0; j < 4; ++j) o[j] = x2[j4 * 4 + j] * rs * fw[j];
            *(f32x4*)(p.out + OFF_Y + (size_t)r * 1024 + cc) = o;
        }
    }
}

constexpr int N_PHASES = 15;

__global__ __launch_bounds__(512, 2) void mega(Params p) {
    extern __shared__ __attribute__((aligned(16))) unsigned char shm[];
    LAS unsigned char* lds = (LAS unsigned char*)shm;
    cg::grid_group grid = cg::this_grid();
    volatile LAS unsigned* xst = (volatile LAS unsigned*)(lds + LDS_BYTES - 16);
    if (otid() == 0) { xst[0] = 0u; xst[1] = 0u; xst[2] = 0u; xst[3] = 0u; }
    __syncthreads();
    const XcdBarrier xb = xcd_barrier_post((unsigned*)(p.ws + WS_BAR), xst);
    unsigned char* ws = p.ws;
    bf16_t* Pb = (bf16_t*)(ws + WS_P);
    bf16_t* Hb = (bf16_t*)(ws + WS_H);
    bf16_t* PA = (bf16_t*)p.out;
    const bf16_t* YN = (const bf16_t*)p.out;
    bf16_t* PB2 = (bf16_t*)(ws + WS_PB);
    const int split_b = (int)gridDim.x > 128 ? 6 * ((int)gridDim.x - 128) : 0;
#ifdef REP_MASK
    bool rep_done = false;
#endif
    for (int ph = p.ph_lo; ph < p.ph_hi; ++ph) {
        GemmArgs g; Epi E; bool is_gemm = false;
        E.mode = 0; E.dst = nullptr; E.ldc = 0; E.dt = (float*)(ws + WS_DT); E.dt_bias = p.in[I_DTB]; E.pa = PA; E.pb = PB2; E.ldpb = 1024;
        E.lbp = p.in[I_LB]; E.xp = p.in[I_XP]; E.xs = p.in[I_XS]; E.mod = (const float*)(ws + WS_MOD); E.x1 = (float*)(ws + WS_P + P_X1);
        g.M = NP; g.lda = 1024; g.K = 1024; g.A = Hb; g.Bt = nullptr; g.N = 0; g.oG = (int)gridDim.x; g.oC = (int)blockIdx.x; g.oBase = 0; g.oLimit = 0x7fffffff;
        bool do_mini = true;
        switch (ph) {
            case 0: prep_phase(p, lds); break;
            case 1: norm_phase(p, 0); break;
            case 2: is_gemm = true; g.Bt = (const bf16_t*)(ws + WS_WSS); g.N = 5376; E.mode = 1; E.dst = Pb; E.ldc = 5120; break;
            case 3: conv_phase(p, xb); break;
            case 4: ssd_phase(p, lds); break;
            case 5: ynorm_phase(p); break;
            case 6: is_gemm = true; g.Bt = (const bf16_t*)(ws + WS_WHG); g.N = 4096; E.mode = 4; E.dst = Pb; E.ldc = 4096; break;
            case 7:
                if ((int)blockIdx.x < 192) gla_phase(p, lds);
                if ((int)blockIdx.x >= 128 && (int)gridDim.x > 128) {
                    is_gemm = true; do_mini = false; g.A = YN; g.lda = 2048; g.K = 2048; g.Bt = (const bf16_t*)(ws + WS_WB); g.N = 1024; E.mode = 0; E.dst = PB2; E.ldc = 1024;
                    g.oG = (int)gridDim.x - 128; g.oC = (int)blockIdx.x - 128; g.oBase = 0; g.oLimit = split_b;
                }
                break;
            case 8: is_gemm = true; g.A = YN; g.lda = 2048; g.K = 2048; g.Bt = (const bf16_t*)(ws + WS_WB); g.N = 1024; E.mode = 0; E.dst = PB2; E.ldc = 1024; g.oBase = split_b; break;
            case 9: is_gemm = true; g.A = (const bf16_t*)(ws + WS_P + P_OBUF); g.Bt = (const bf16_t*)(ws + WS_WA); g.N = 1024; E.mode = 0; E.dst = PA; E.ldc = 1024; break;
            case 10: is_gemm = true; g.Bt = (const bf16_t*)(ws + WS_WG); g.N = 2048; E.mode = 2; break;
            case 11: is_gemm = true; g.A = PA; g.Bt = (const bf16_t*)(ws + WS_WO); g.N = 1024; E.mode = 3; break;
            case 12: norm_phase(p, 1); break;
            case 13: is_gemm = true; g.Bt = (const bf16_t*)(ws + WS_WQ); g.N = 2048; E.mode = 5; E.dst = (bf16_t*)(ws + WS_P + P_QB); E.ldc = 2048; break;
            case 14: expert_phase(p, lds); break;
            default: break;
        }
        if (is_gemm) { gemm_phase(lds, g, E); if (do_mini) mini_gemm(g, E); }
#ifdef REP_MASK
        if (((REP_MASK >> ph) & 1) && !rep_done) { rep_done = true; --ph; grid.sync(); continue; }
        rep_done = false;
#endif
        if (ph + 1 < p.ph_hi) { if (ph == 0) grid.sync(); else xcd_barrier(xb); }
    }
}

extern "C" void kernel_launch(void* const* d_in, const int* in_sizes, int n_in, void* d_out, int out_size, void* d_ws, size_t ws_size, hipStream_t stream) {
    static int grid_blocks = 0;
    if (grid_blocks == 0) {
        if (n_in != 29 || ws_size < WS_END) { fprintf(stderr, "kernel_launch: unexpected n_in %d / ws_size %zu (need %zu)\n", n_in, ws_size, (size_t)WS_END); grid_blocks = -1; return; }
        int dev = 0, cus = 0, per_cu = 0;
        hipGetDevice(&dev);
        hipDeviceGetAttribute(&cus, hipDeviceAttributeMultiprocessorCount, dev);
        if (hipFuncSetAttribute((const void*)mega, hipFuncAttributeMaxDynamicSharedMemorySize, LDS_BYTES) != hipSuccess) { fprintf(stderr, "kernel_launch: hipFuncSetAttribute failed\n"); }
        if (hipOccupancyMaxActiveBlocksPerMultiprocessor(&per_cu, (const void*)mega, 512, LDS_BYTES) != hipSuccess || per_cu < 1) { fprintf(stderr, "kernel_launch: occupancy query gave %d\n", per_cu); per_cu = 1; }
        (void)hipGetLastError();
        grid_blocks = cus * per_cu;
    }
    if (grid_blocks < 0) return;
    if (hipMemsetAsync((char*)d_ws + WS_BAR, 0, 16384, stream) != hipSuccess) { fprintf(stderr, "kernel_launch: memset of the barrier words failed\n"); return; }
    Params p{};
    for (int i = 0; i < 29; ++i) p.in[i] = (const float*)d_in[i];
    p.out = (float*)d_out; p.ws = (unsigned char*)d_ws;
#ifdef MULTI_LAUNCH
    for (int ph = 0; ph < N_PHASES; ++ph) {
        p.ph_lo = ph; p.ph_hi = ph + 1;
        hipLaunchKernelGGL(mega, dim3(grid_blocks), dim3(512), LDS_BYTES, stream, p);
    }
#else
    p.ph_lo = 0; p.ph_hi = N_PHASES;
    void* args[] = {&p};
    hipError_t e = hipLaunchCooperativeKernel((const void*)mega, dim3(grid_blocks), dim3(512), args, LDS_BYTES, stream);
    if (e != hipSuccess) fprintf(stderr, "cooperative launch failed: %s (grid %d)\n", hipGetErrorString(e), grid_blocks);
#endif
}
```
